# Optimizing an MI355X kernel written in HIP

```python
import math
import jax, jax.numpy as jnp
from jax import lax
import numpy as np

D_MODEL = 1024
BATCH = 8
SEQ = 4096
DEPTH = 2

N_A_LAYERS = max(1, DEPTH // 2)
N_B_LAYERS = DEPTH - N_A_LAYERS
SGU_CHUNK = 128
SGU_GROUPS = 8
D_SGU = 3 * D_MODEL
SGU_GROUP_DIM = D_SGU // SGU_GROUPS
HEAD_DIM = 64
N_HEADS = D_MODEL // HEAD_DIM
MOBA_BLOCK = 256
MOBA_TOPK = 3
Q_CHUNK = 128
N_EXPERTS = 32
TOP_K = 4
D_EXPERT = D_MODEL
SWIGLU_LIMIT = 7.0
SWIGLU_ALPHA = 1.702
EXPERT_BLOCK = 256
EPS = 1e-6

kernel_name = 'hybrid_sgu_moba_moe'


def _rmsnorm(x, g):
    xf = x.astype(jnp.float32)
    y = xf * lax.rsqrt(jnp.mean(xf * xf, axis=-1, keepdims=True) + EPS)
    return (y * g.astype(jnp.float32)).astype(x.dtype)


def _modulate(x, g, shift, scale):
    return _rmsnorm(x, g) * (1 + scale[:, None, :]) + shift[:, None, :]


def _alibi_slopes():
    return 2.0 ** (-8.0 * jnp.arange(1, N_HEADS + 1, dtype=jnp.float32) / N_HEADS)


def _chunked_sgu(h, w_in, b_in, v_g, w_s, b_s, w_out):
    B, S, _ = h.shape
    z = jax.nn.gelu(h @ w_in + b_in)
    u, v = jnp.split(z, 2, axis=-1)
    v = _rmsnorm(v, v_g).reshape(B, S // SGU_CHUNK, SGU_CHUNK, SGU_GROUPS, SGU_GROUP_DIM)
    causal = jnp.tril(jnp.ones((SGU_CHUNK, SGU_CHUNK), dtype=bool))
    ws = jnp.where(causal, w_s, jnp.zeros((), w_s.dtype))
    mixed = jnp.einsum('gts,bnsgc->bntgc', ws, v) + b_s.T[:, :, None]
    y = u * mixed.reshape(B, S, D_SGU)
    return y @ w_out


def _shared_kv(x, c, kv_ada_w, kv_ada_b, kv_norm_g, w_kv, k_norm_g):
    B, S, _ = x.shape
    shift, scale = jnp.split(jax.nn.silu(c) @ kv_ada_w + kv_ada_b, 2, axis=-1)
    h = _modulate(x, kv_norm_g, shift, scale)
    k, v = jnp.split(h @ w_kv, 2, axis=-1)
    k = _rmsnorm(k.reshape(B, S, N_HEADS, HEAD_DIM), k_norm_g)
    v = v.reshape(B, S, N_HEADS, HEAD_DIM)
    n_blocks = -(-S // MOBA_BLOCK)
    pad = n_blocks * MOBA_BLOCK - S

    def to_blocks(t):
        t = jnp.pad(t, ((0, 0), (0, pad), (0, 0), (0, 0)))
        return t.reshape(B, n_blocks, MOBA_BLOCK, N_HEADS, HEAD_DIM).transpose(0, 3, 1, 2, 4)

    kb, vb = to_blocks(k), to_blocks(v)
    k_mean = jnp.mean(kb.astype(jnp.float32), axis=3).astype(kb.dtype)
    return kb, vb, k_mean


def _moba_attention(q, kb, vb, k_mean):
    B, S, H, Dh = q.shape
    n_blocks = kb.shape[2]
    n_sel = min(MOBA_TOPK, n_blocks)
    n_chunks = S // Q_CHUNK
    scale = HEAD_DIM ** -0.5
    slopes = _alibi_slopes()
    qh = q.transpose(0, 2, 1, 3)
    head_ix = jnp.arange(H)[:, None, None]
    blk_ar = jnp.arange(n_blocks)
    key_ar = jnp.arange(MOBA_BLOCK)

    def chunk(args):
        b, ci = args
        t0 = ci * Q_CHUNK
        own = t0 // MOBA_BLOCK
        qc = lax.dynamic_slice_in_dim(qh[b], t0, Q_CHUNK, axis=1)
        kbb, vbb = kb[b], vb[b]
        qpos = t0 + jnp.arange(Q_CHUNK)
        gate = jnp.einsum('hqd,hnd->hqn', qc, k_mean[b]).astype(jnp.float32)
        gate = jnp.where(blk_ar < own, gate, -jnp.inf)
        _, sel = lax.top_k(gate, n_sel)
        sel_valid = jnp.arange(n_sel) < own
        ksel = kbb[head_ix, sel]
        vsel = vbb[head_ix, sel]
        s_sel = jnp.einsum('hqd,hqjkd->hqjk', qc, ksel).astype(jnp.float32) * scale
        pos_sel = sel[..., None] * MOBA_BLOCK + key_ar
        s_sel = s_sel - slopes[:, None, None, None] * jnp.abs(qpos[None, :, None, None] - pos_sel).astype(jnp.float32)
        s_sel = jnp.where(sel_valid[None, None, :, None], s_sel, -jnp.inf)
        kown, vown = kbb[:, own], vbb[:, own]
        d_own = qpos[:, None] - (own * MOBA_BLOCK + key_ar)[None, :]
        s_own = jnp.einsum('hqd,hkd->hqk', qc, kown).astype(jnp.float32) * scale
        s_own = s_own - slopes[:, None, None] * jnp.abs(d_own).astype(jnp.float32)
        s_own = jnp.where(d_own >= 0, s_own, -jnp.inf)
        n_k = n_sel * MOBA_BLOCK
        p = jax.nn.softmax(jnp.concatenate([s_sel.reshape(H, Q_CHUNK, n_k), s_own], axis=-1), axis=-1).astype(vb.dtype)
        p_sel = p[..., :n_k].reshape(H, Q_CHUNK, n_sel, MOBA_BLOCK)
        p_own = p[..., n_k:]
        o = jnp.einsum('hqjk,hqjkd->hqd', p_sel, vsel) + jnp.einsum('hqk,hkd->hqd', p_own, vown)
        return o.transpose(1, 0, 2).reshape(Q_CHUNK, H * Dh)

    b_ids = jnp.repeat(jnp.arange(B), n_chunks)
    c_ids = jnp.tile(jnp.arange(n_chunks), B)
    out = lax.map(chunk, (b_ids, c_ids))
    return out.reshape(B, S, H * Dh)


def _moba_mixer(h, w_q, q_g, w_o, kb, vb, k_mean):
    B, S, _ = h.shape
    q = _rmsnorm((h @ w_q).reshape(B, S, N_HEADS, HEAD_DIM), q_g)
    return _moba_attention(q, kb, vb, k_mean) @ w_o


def _moe(h, w_router, b_router, w_gate, b_gate, w_up, b_up, w_down, b_down):
    B, S, D = h.shape
    N = B * S
    xf = h.reshape(N, D)
    logits = (xf @ w_router + b_router).astype(jnp.float32)
    top_val, top_idx = lax.top_k(logits, TOP_K)
    probs = jax.nn.softmax(top_val, axis=-1)
    A = N * TOP_K
    e_flat = top_idx.reshape(A)
    tok_flat = jnp.arange(A) // TOP_K
    p_flat = probs.reshape(A)
    order = jnp.argsort(e_flat, stable=True)
    e_s, tok_s, p_s = e_flat[order], tok_flat[order], p_flat[order]
    counts = jnp.bincount(e_flat, length=N_EXPERTS)
    padded = (counts + EXPERT_BLOCK - 1) // EXPERT_BLOCK * EXPERT_BLOCK
    start = jnp.cumsum(counts) - counts
    pend = jnp.cumsum(padded)
    pstart = pend - padded
    dest = pstart[e_s] + jnp.arange(A) - start[e_s]
    R = A + N_EXPERTS * EXPERT_BLOCK
    n_blk = R // EXPERT_BLOCK
    row_tok = jnp.full((R,), N, dtype=jnp.int32).at[dest].set(tok_s.astype(jnp.int32))
    row_p = jnp.zeros((R,), jnp.float32).at[dest].set(p_s)
    blk_exp = jnp.minimum(jnp.searchsorted(pend, jnp.arange(n_blk) * EXPERT_BLOCK, side='right'), N_EXPERTS - 1)
    xpad = jnp.concatenate([xf, jnp.zeros((1, D), xf.dtype)], axis=0)

    def expert_block(args):
        toks, e = args
        xb = xpad[toks]
        g = jnp.minimum(xb @ w_gate[e] + b_gate[e], SWIGLU_LIMIT)
        u = jnp.clip(xb @ w_up[e] + b_up[e], -SWIGLU_LIMIT, SWIGLU_LIMIT)
        a = g * jax.nn.sigmoid(SWIGLU_ALPHA * g) * (u + 1)
        return a @ w_down[e] + b_down[e]

    y = lax.map(expert_block, (row_tok.reshape(n_blk, EXPERT_BLOCK), blk_exp))
    y = y.reshape(R, D) * row_p[:, None].astype(y.dtype)
    out = jax.ops.segment_sum(y, row_tok, num_segments=N + 1)[:N]
    return out.reshape(B, S, D)


def setup_inputs(seed: int = 0) -> dict:
    key = jax.random.key(seed)
    ks = iter(jax.random.split(key, 40))
    f32 = jnp.float32

    def nrm(shape, s):
        return jax.random.normal(next(ks), shape, f32) * s

    def gain(shape):
        return 1.0 + nrm(shape, 0.02)

    D, HD = D_MODEL, N_HEADS * HEAD_DIM
    return {
        'x': nrm((BATCH, SEQ, D), 1.0),
        'c': nrm((BATCH, D), 1.0),
        'ada_w': nrm((DEPTH, D, 6 * D), 0.5 * D ** -0.5),
        'ada_b': nrm((DEPTH, 6 * D), 0.02),
        'norm1_g': gain((DEPTH, D)),
        'norm2_g': gain((DEPTH, D)),
        'sgu_w_in': nrm((N_A_LAYERS, D, 2 * D_SGU), D ** -0.5),
        'sgu_b_in': nrm((N_A_LAYERS, 2 * D_SGU), 0.02),
        'sgu_v_g': gain((N_A_LAYERS, D_SGU)),
        'sgu_w_s': nrm((N_A_LAYERS, SGU_GROUPS, SGU_CHUNK, SGU_CHUNK), SGU_CHUNK ** -0.5),
        'sgu_b_s': 1.0 + nrm((N_A_LAYERS, SGU_GROUPS, SGU_CHUNK), 0.1),
        'sgu_w_out': nrm((N_A_LAYERS, D_SGU, D), D_SGU ** -0.5),
        'kv_ada_w': nrm((D, 2 * D), 0.5 * D ** -0.5),
        'kv_ada_b': nrm((2 * D,), 0.02),
        'kv_norm_g': gain((D,)),
        'w_kv': nrm((D, 2 * HD), D ** -0.5),
        'k_norm_g': gain((HEAD_DIM,)),
        'attn_w_q': nrm((N_B_LAYERS, D, HD), D ** -0.5),
        'q_norm_g': gain((N_B_LAYERS, HEAD_DIM)),
        'attn_w_o': nrm((N_B_LAYERS, HD, D), HD ** -0.5),
        'moe_w_router': nrm((DEPTH, D, N_EXPERTS), D ** -0.5),
        'moe_b_router': nrm((DEPTH, N_EXPERTS), 0.01),
        'moe_w_gate': nrm((DEPTH, N_EXPERTS, D, D_EXPERT), D ** -0.5),
        'moe_b_gate': nrm((DEPTH, N_EXPERTS, D_EXPERT), 0.02),
        'moe_w_up': nrm((DEPTH, N_EXPERTS, D, D_EXPERT), D ** -0.5),
        'moe_b_up': nrm((DEPTH, N_EXPERTS, D_EXPERT), 0.02),
        'moe_w_down': nrm((DEPTH, N_EXPERTS, D_EXPERT, D), D_EXPERT ** -0.5),
        'moe_b_down': nrm((DEPTH, N_EXPERTS, D), 0.02),
    }


def reference(x, c, ada_w, ada_b, norm1_g, norm2_g, sgu_w_in, sgu_b_in, sgu_v_g, sgu_w_s, sgu_b_s, sgu_w_out,
              kv_ada_w, kv_ada_b, kv_norm_g, w_kv, k_norm_g, attn_w_q, q_norm_g, attn_w_o,
              moe_w_router, moe_b_router, moe_w_gate, moe_b_gate, moe_w_up, moe_b_up, moe_w_down, moe_b_down):
    c_act = jax.nn.silu(c)
    kb = vb = k_mean = None
    for l in range(DEPTH):
        mod = c_act @ ada_w[l] + ada_b[l]
        sh1, sc1, g1, sh2, sc2, g2 = jnp.split(mod, 6, axis=-1)
        if l < N_A_LAYERS:
            h = _modulate(x, norm1_g[l], sh1, sc1)
            m = _chunked_sgu(h, sgu_w_in[l], sgu_b_in[l], sgu_v_g[l], sgu_w_s[l], sgu_b_s[l], sgu_w_out[l])
        else:
            if l == N_A_LAYERS:
                kb, vb, k_mean = _shared_kv(x, c, kv_ada_w, kv_ada_b, kv_norm_g, w_kv, k_norm_g)
            j = l - N_A_LAYERS
            h = _modulate(x, norm1_g[l], sh1, sc1)
            m = _moba_mixer(h, attn_w_q[j], q_norm_g[j], attn_w_o[j], kb, vb, k_mean)
        x = x + g1[:, None, :] * m
        h2 = _modulate(x, norm2_g[l], sh2, sc2)
        x = x + g2[:, None, :] * _moe(h2, moe_w_router[l], moe_b_router[l], moe_w_gate[l], moe_b_gate[l],
                                       moe_w_up[l], moe_b_up[l], moe_w_down[l], moe_b_down[l])
    return x
```

```cpp
#include <hip/hip_runtime.h>
#include <stdint.h>
#include <stdio.h>

typedef unsigned short bf16;
typedef short bf16x8 __attribute__((ext_vector_type(8)));
typedef float f32x4 __attribute__((ext_vector_type(4)));
typedef unsigned u32x4 __attribute__((ext_vector_type(4)));

constexpr int NTOK = 32768, DM = 1024, NB = 8, SEQ = 4096, DS = 3072, NE = 32, NH = 16, HD = 64;
constexpr int CAP = 32768;
constexpr float EPS = 1e-6f;

constexpr size_t MiB = 1u << 20;
constexpr size_t WS_CTL = 0;
constexpr size_t WS_MOD = 1 * MiB;
constexpr size_t WS_KVMOD = WS_MOD + 512 * 1024;
constexpr size_t WS_VRSTD = 2 * MiB;
constexpr size_t WS_KMEAN = 3 * MiB;
constexpr size_t WS_ROWT = 4 * MiB;
constexpr size_t WS_ROWP = 8 * MiB;
constexpr size_t WS_POFF = 12 * MiB;
constexpr size_t WS_HA = 16 * MiB;
constexpr size_t WS_HB = 80 * MiB;
constexpr size_t WS_X = 144 * MiB;
constexpr size_t WS_U = WS_X, WS_V = WS_X + 192 * MiB;
constexpr size_t WS_A = WS_X, WS_Y = WS_X + 272 * MiB;
constexpr size_t WS_Q = WS_X, WS_K = WS_X + 64 * MiB, WS_VV = WS_X + 128 * MiB, WS_O = WS_X + 192 * MiB;
constexpr size_t WS_END = WS_X + 528 * MiB;

__device__ __forceinline__ unsigned f2bf(float f) { unsigned u = __builtin_bit_cast(unsigned, f); return (u + 0x7fffu + ((u >> 16) & 1u)) >> 16; }
__device__ __forceinline__ float bf2f(unsigned b) { return __builtin_bit_cast(float, b << 16); }
__device__ __forceinline__ unsigned pk2(float lo, float hi) { return f2bf(lo) | (f2bf(hi) << 16); }
__device__ __forceinline__ float wave_sum(float v) {
#pragma unroll
    for (int o = 32; o >= 1; o >>= 1) v += __shfl_xor(v, o);
    return v;
}
__device__ __forceinline__ float wave_max(float v) {
#pragma unroll
    for (int o = 32; o >= 1; o >>= 1) v = fmaxf(v, __shfl_xor(v, o));
    return v;
}
__device__ __forceinline__ float gelu_tanh(float x) {
    const float y = 0.7978845608028654f * (x + 0.044715f * x * x * x);
    return x / (1.0f + __expf(-2.0f * y));
}

__global__ __launch_bounds__(256) void k_adaln(const float* c, const float* ada_w, const float* ada_b, const float* kv_w, const float* kv_b, float* mod, float* kvmod) {
    __shared__ float cact[NB][DM];
    for (int i = threadIdx.x; i < NB * DM; i += 256) { const float v = c[i]; cact[i / DM][i % DM] = v / (1.0f + __expf(-v)); }
    __syncthreads();
    const int j = blockIdx.x * 256 + threadIdx.x;
    const float* W; int ld, col; float bias; float* out; int ostride;
    if (j < 2 * 6144) { const int l = j / 6144; col = j % 6144; W = ada_w + (size_t)l * DM * 6144; ld = 6144; bias = ada_b[l * 6144 + col]; out = mod + (size_t)l * NB * 6144 + col; ostride = 6144; }
    else { col = j - 2 * 6144; W = kv_w; ld = 2048; bias = kv_b[col]; out = kvmod + col; ostride = 2048; }
    float acc[NB];
#pragma unroll
    for (int b = 0; b < NB; ++b) acc[b] = 0.f;
    for (int k = 0; k < DM; ++k) { const float w = W[(size_t)k * ld + col];
#pragma unroll
        for (int b = 0; b < NB; ++b) acc[b] += cact[b][k] * w; }
#pragma unroll
    for (int b = 0; b < NB; ++b) out[(size_t)b * ostride] = acc[b] + bias;
}

struct ModP { const float* g; const float* shift; const float* scale; long bstride; bf16* out; };
template <int NOUT> __global__ __launch_bounds__(256) void k_norm_mod(const float* x, ModP p0, ModP p1) {
    const int lane = threadIdx.x & 63, gw = blockIdx.x * 4 + (threadIdx.x >> 6), ngw = gridDim.x * 4;
    for (int row = gw; row < NTOK; row += ngw) {
        const f32x4* xr = (const f32x4*)(x + (size_t)row * DM) + lane; f32x4 v[4]; float ss = 0.f;
#pragma unroll
        for (int j = 0; j < 4; ++j) { v[j] = xr[64 * j]; ss += v[j].x * v[j].x + v[j].y * v[j].y + v[j].z * v[j].z + v[j].w * v[j].w; }
        const float rstd = rsqrtf(wave_sum(ss) * (1.0f / DM) + EPS); const int b = row / SEQ;
#pragma unroll
        for (int o = 0; o < NOUT; ++o) { const ModP& p = o ? p1 : p0;
#pragma unroll
            for (int j = 0; j < 4; ++j) { const int c4 = lane + 64 * j; const f32x4 g = ((const f32x4*)p.g)[c4], sh = ((const f32x4*)(p.shift + (size_t)b * p.bstride))[c4], sc = ((const f32x4*)(p.scale + (size_t)b * p.bstride))[c4];
                const f32x4 h = v[j] * rstd * g * (sc + 1.0f) + sh;
                uint2 w; w.x = pk2(h.x, h.y); w.y = pk2(h.z, h.w); ((uint2*)(p.out + (size_t)row * DM))[c4] = w; } }
    }
}

constexpr int LDT = 40;
template <class AF, class BF, class EF> __global__ __launch_bounds__(256) void gemm_simple(AF af, BF bf, EF ef, long K_) {
    const int K = (int)K_;
    __shared__ __attribute__((aligned(16))) bf16 As[128 * LDT];
    __shared__ __attribute__((aligned(16))) bf16 Bs[128 * LDT];
    const int nt = blockIdx.x, mt = blockIdx.y, z = blockIdx.z, tid = threadIdx.x, lane = tid & 63, wid = tid >> 6, wr = wid >> 1, wc = wid & 1;
    if (!af.active(z, mt)) return;
    const bf16* arow = af.row(z, mt * 128 + (tid >> 1)); const int akseg = (tid & 1) * 16;
    const int bk = tid >> 3, bnseg = (tid & 7) * 16;
    f32x4 acc[4][4];
#pragma unroll
    for (int i = 0; i < 4; ++i)
#pragma unroll
        for (int j = 0; j < 4; ++j) acc[i][j] = (f32x4){0.f, 0.f, 0.f, 0.f};
    for (int k0 = 0; k0 < K; k0 += 32) {
        u32x4 a0 = (u32x4){0, 0, 0, 0}, a1 = a0;
        if (arow) { a0 = *(const u32x4*)(arow + k0 + akseg); a1 = *(const u32x4*)(arow + k0 + akseg + 8); }
        const float* bp = bf.ptr(z, k0 + bk, nt * 128 + bnseg);
        f32x4 b0 = ((const f32x4*)bp)[0], b1 = ((const f32x4*)bp)[1], b2 = ((const f32x4*)bp)[2], b3 = ((const f32x4*)bp)[3];
        __syncthreads();
        *(u32x4*)(As + (tid >> 1) * LDT + akseg) = a0; *(u32x4*)(As + (tid >> 1) * LDT + akseg + 8) = a1;
        const float bv[16] = {b0.x, b0.y, b0.z, b0.w, b1.x, b1.y, b1.z, b1.w, b2.x, b2.y, b2.z, b2.w, b3.x, b3.y, b3.z, b3.w};
#pragma unroll
        for (int i = 0; i < 16; ++i) Bs[(bnseg + i) * LDT + bk] = (bf16)f2bf(bv[i]);
        __syncthreads();
        bf16x8 af_[4], bf_[4];
#pragma unroll
        for (int i = 0; i < 4; ++i) { af_[i] = *(const bf16x8*)(As + (wr * 64 + i * 16 + (lane & 15)) * LDT + 8 * (lane >> 4)); bf_[i] = *(const bf16x8*)(Bs + (wc * 64 + i * 16 + (lane & 15)) * LDT + 8 * (lane >> 4)); }
#pragma unroll
        for (int i = 0; i < 4; ++i)
#pragma unroll
            for (int j = 0; j < 4; ++j) acc[i][j] = __builtin_amdgcn_mfma_f32_16x16x32_bf16(af_[i], bf_[j], acc[i][j], 0, 0, 0);
    }
    ef(z, mt, nt, wr, wc, lane, acc);
}

struct ADense { const bf16* A; long lda; __device__ bool active(int, int) const { return true; } __device__ const bf16* row(int, int m) const { return A + (size_t)m * lda; } };
struct AGather { const bf16* H; const int* rowt; const int* cnt; __device__ bool active(int e, int mt) const { return mt * 128 < cnt[e]; }
    __device__ const bf16* row(int e, int r) const { return r < cnt[e] ? H + (size_t)(rowt[e * CAP + r] >> 2) * DM : nullptr; } };
struct AExpert { const bf16* Abuf; const int* poff; const int* cnt; __device__ bool active(int e, int mt) const { return mt * 128 < cnt[e]; }
    __device__ const bf16* row(int e, int r) const { return r < cnt[e] ? Abuf + (size_t)(poff[e] + r) * DM : nullptr; } };
struct BDense { const float* B; long ldb; __device__ const float* ptr(int, int k, int n) const { return B + (size_t)k * ldb + n; } };
struct BExpert { const float* B; __device__ const float* ptr(int e, int k, int n) const { return B + ((size_t)e * DM + k) * DM + n; } };
struct BGateUp { const float* G; const float* U;
    __device__ const float* ptr(int e, int k, int n) const { const int j = (n >> 7) * 64 + ((n >> 6) & 1) * 32 + (n & 31); const float* base = ((n >> 5) & 1) ? U : G; return base + ((size_t)e * DM + k) * DM + j; } };

struct EpiSguIn { const float* bias; bf16* U; bf16* V;
    __device__ void operator()(int, int mt, int nt, int wr, int wc, int lane, f32x4 (&acc)[4][4]) const {
#pragma unroll
        for (int mi = 0; mi < 4; ++mi)
#pragma unroll
            for (int ni = 0; ni < 4; ++ni)
#pragma unroll
                for (int r = 0; r < 4; ++r) { const int row = mt * 128 + wr * 64 + mi * 16 + 4 * (lane >> 4) + r, col = nt * 128 + wc * 64 + ni * 16 + (lane & 15);
                    const float zv = gelu_tanh(acc[mi][ni][r] + bias[col]);
                    if (col < DS) U[(size_t)row * DS + col] = (bf16)f2bf(zv); else V[(size_t)row * DS + col - DS] = (bf16)f2bf(zv); }
    } };
struct EpiResid { const float* xin; float* xout; const float* gate; long gstride;
    __device__ void operator()(int, int mt, int nt, int wr, int wc, int lane, f32x4 (&acc)[4][4]) const {
#pragma unroll
        for (int mi = 0; mi < 4; ++mi)
#pragma unroll
            for (int ni = 0; ni < 4; ++ni)
#pragma unroll
                for (int r = 0; r < 4; ++r) { const int row = mt * 128 + wr * 64 + mi * 16 + 4 * (lane >> 4) + r, col = nt * 128 + wc * 64 + ni * 16 + (lane & 15);
                    const size_t o = (size_t)row * DM + col; xout[o] = xin[o] + gate[(size_t)(row / SEQ) * gstride + col] * acc[mi][ni][r]; }
    } };
struct EpiSwiglu { const float* bg; const float* bu; bf16* Abuf; const int* poff; const int* cnt;
    __device__ void operator()(int e, int mt, int nt, int wr, int wc, int lane, f32x4 (&acc)[4][4]) const {
#pragma unroll
        for (int mi = 0; mi < 4; ++mi)
#pragma unroll
            for (int ni = 0; ni < 2; ++ni)
#pragma unroll
                for (int r = 0; r < 4; ++r) { const int rr = mt * 128 + wr * 64 + mi * 16 + 4 * (lane >> 4) + r; const int j = nt * 64 + wc * 32 + ni * 16 + (lane & 15);
                    if (rr < cnt[e]) { float g = acc[mi][ni][r] + bg[e * DM + j], u = acc[mi][ni + 2][r] + bu[e * DM + j];
                        g = fminf(g, 7.0f); u = fminf(fmaxf(u, -7.0f), 7.0f);
                        const float a = g / (1.0f + __expf(-1.702f * g)) * (u + 1.0f);
                        Abuf[(size_t)(poff[e] + rr) * DM + j] = (bf16)f2bf(a); } }
    } };
struct EpiDown { const float* bd; bf16* Y; const int* rowt; const float* rowp; const int* cnt;
    __device__ void operator()(int e, int mt, int nt, int wr, int wc, int lane, f32x4 (&acc)[4][4]) const {
#pragma unroll
        for (int mi = 0; mi < 4; ++mi)
#pragma unroll
            for (int r = 0; r < 4; ++r) { const int rr = mt * 128 + wr * 64 + mi * 16 + 4 * (lane >> 4) + r;
                if (rr < cnt[e]) { const int tokk = rowt[e * CAP + rr]; const float p = rowp[e * CAP + rr];
#pragma unroll
                    for (int ni = 0; ni < 4; ++ni) { const int col = nt * 128 + wc * 64 + ni * 16 + (lane & 15); Y[(size_t)tokk * DM + col] = (bf16)f2bf((acc[mi][ni][r] + bd[e * DM + col]) * p); } } }
    } };
struct EpiHead { const float* g; bf16* O0; bf16* O1; long normcols;
    __device__ void operator()(int, int mt, int nt, int wr, int wc, int lane, f32x4 (&acc)[4][4]) const {
        const int col0 = nt * 128 + wc * 64; const bool norm = col0 < normcols;
#pragma unroll
        for (int mi = 0; mi < 4; ++mi)
#pragma unroll
            for (int r = 0; r < 4; ++r) { const int row = mt * 128 + wr * 64 + mi * 16 + 4 * (lane >> 4) + r; float rstd = 1.0f;
                if (norm) { float ss = 0.f;
#pragma unroll
                    for (int ni = 0; ni < 4; ++ni) ss += acc[mi][ni][r] * acc[mi][ni][r];
                    ss += __shfl_xor(ss, 1); ss += __shfl_xor(ss, 2); ss += __shfl_xor(ss, 4); ss += __shfl_xor(ss, 8);
                    rstd = rsqrtf(ss * (1.0f / HD) + EPS); }
#pragma unroll
                for (int ni = 0; ni < 4; ++ni) { const int d = ni * 16 + (lane & 15), col = col0 + d; float v = acc[mi][ni][r];
                    if (norm) v = v * rstd * g[d];
                    if (col < DM) O0[(size_t)row * DM + col] = (bf16)f2bf(v); else O1[(size_t)row * DM + col - DM] = (bf16)f2bf(v); } }
    } };

__global__ __launch_bounds__(256) void k_vrstd(const bf16* V, float* vrstd) {
    const int lane = threadIdx.x & 63, row = blockIdx.x * 4 + (threadIdx.x >> 6);
    const u32x4* vr = (const u32x4*)(V + (size_t)row * DS); float ss = 0.f;
    for (int i = lane; i < DS / 8; i += 64) { const u32x4 w = vr[i]; const unsigned ww[4] = {w.x, w.y, w.z, w.w};
#pragma unroll
        for (int j = 0; j < 4; ++j) { const float a = bf2f(ww[j] & 0xffffu), b = bf2f(ww[j] >> 16); ss += a * a + b * b; } }
    ss = wave_sum(ss); if (lane == 0) vrstd[row] = rsqrtf(ss * (1.0f / DS) + EPS);
}
constexpr int LDM = 136;
__global__ __launch_bounds__(256) void k_sgu_mix(bf16* U, const bf16* V, const float* vrstd, const float* w_s, const float* b_s, const float* v_g) {
    __shared__ __attribute__((aligned(16))) bf16 As[128 * LDM];
    __shared__ __attribute__((aligned(16))) bf16 Bs[128 * LDM];
    const int ct = blockIdx.x, g = blockIdx.y, chunk = blockIdx.z, tid = threadIdx.x, lane = tid & 63, wid = tid >> 6, wr = wid >> 1, wc = wid & 1;
    const int tok0 = chunk * 128, ch0 = g * 384 + ct * 128;
    for (int i = tid; i < 128 * 128; i += 256) { const int t = i >> 7, s = i & 127; const float w = (s <= t) ? w_s[((size_t)g * 128 + t) * 128 + s] * vrstd[tok0 + s] : 0.f; As[t * LDM + s] = (bf16)f2bf(w); }
    for (int i = tid; i < 128 * 16; i += 256) { const int s = i >> 4, c8 = (i & 15) * 8; const u32x4 w = *(const u32x4*)(V + (size_t)(tok0 + s) * DS + ch0 + c8); const unsigned ww[4] = {w.x, w.y, w.z, w.w};
#pragma unroll
        for (int j = 0; j < 4; ++j) { Bs[(c8 + 2 * j) * LDM + s] = (bf16)(ww[j] & 0xffffu); Bs[(c8 + 2 * j + 1) * LDM + s] = (bf16)(ww[j] >> 16); } }
    __syncthreads();
    f32x4 acc[4][4];
#pragma unroll
    for (int i = 0; i < 4; ++i)
#pragma unroll
        for (int j = 0; j < 4; ++j) acc[i][j] = (f32x4){0.f, 0.f, 0.f, 0.f};
#pragma unroll
    for (int ks = 0; ks < 4; ++ks) { bf16x8 af_[4], bf_[4];
#pragma unroll
        for (int i = 0; i < 4; ++i) { af_[i] = *(const bf16x8*)(As + (wr * 64 + i * 16 + (lane & 15)) * LDM + ks * 32 + 8 * (lane >> 4)); bf_[i] = *(const bf16x8*)(Bs + (wc * 64 + i * 16 + (lane & 15)) * LDM + ks * 32 + 8 * (lane >> 4)); }
#pragma unroll
        for (int i = 0; i < 4; ++i)
#pragma unroll
            for (int j = 0; j < 4; ++j) acc[i][j] = __builtin_amdgcn_mfma_f32_16x16x32_bf16(af_[i], bf_[j], acc[i][j], 0, 0, 0); }
#pragma unroll
    for (int mi = 0; mi < 4; ++mi)
#pragma unroll
        for (int ni = 0; ni < 4; ++ni)
#pragma unroll
            for (int r = 0; r < 4; ++r) { const int t = wr * 64 + mi * 16 + 4 * (lane >> 4) + r, c = wc * 64 + ni * 16 + (lane & 15), ch = ch0 + c; const size_t o = (size_t)(tok0 + t) * DS + ch;
                const float y = bf2f(U[o]) * (v_g[ch] * acc[mi][ni][r] + b_s[g * 128 + t]); U[o] = (bf16)f2bf(y); }
}

__global__ __launch_bounds__(256) void k_router(const float* x, const float* g, const float* shift, const float* scale, long bstride, const float* wr_, const float* br_, bf16* H, int* cnt, int* rowt, float* rowp) {
    __shared__ float hs[4][DM];
    const int lane = threadIdx.x & 63, w = threadIdx.x >> 6, row = blockIdx.x * 4 + w, b = row / SEQ;
    const f32x4* xr = (const f32x4*)(x + (size_t)row * DM) + lane; f32x4 v[4]; float ss = 0.f;
#pragma unroll
    for (int j = 0; j < 4; ++j) { v[j] = xr[64 * j]; ss += v[j].x * v[j].x + v[j].y * v[j].y + v[j].z * v[j].z + v[j].w * v[j].w; }
    const float rstd = rsqrtf(wave_sum(ss) * (1.0f / DM) + EPS);
#pragma unroll
    for (int j = 0; j < 4; ++j) { const int c4 = lane + 64 * j; const f32x4 gg = ((const f32x4*)g)[c4], sh = ((const f32x4*)(shift + (size_t)b * bstride))[c4], sc = ((const f32x4*)(scale + (size_t)b * bstride))[c4];
        const f32x4 h = v[j] * rstd * gg * (sc + 1.0f) + sh; ((f32x4*)hs[w])[c4] = h;
        uint2 o; o.x = pk2(h.x, h.y); o.y = pk2(h.z, h.w); ((uint2*)(H + (size_t)row * DM))[c4] = o; }
    __syncthreads();
    const int e = lane & 31, half = lane >> 5; float acc = 0.f;
    for (int i = 0; i < 512; ++i) { const int k = half * 512 + i; acc += hs[w][k] * wr_[k * NE + e]; }
    acc += __shfl_xor(acc, 32); float val = acc + br_[e]; if (lane >= 32) val = -INFINITY;
    float tv[4]; int ti[4];
#pragma unroll
    for (int k = 0; k < 4; ++k) { const float m = wave_max(val); const unsigned long long bal = __ballot(val == m); const int idx = __ffsll((long long)bal) - 1; tv[k] = m; ti[k] = idx; if (lane == idx) val = -INFINITY; }
    float pe[4], s = 0.f;
#pragma unroll
    for (int k = 0; k < 4; ++k) { pe[k] = __expf(tv[k] - tv[0]); s += pe[k]; }
    if (lane < 4) { const int ex = lane == 0 ? ti[0] : lane == 1 ? ti[1] : lane == 2 ? ti[2] : ti[3]; const float p = (lane == 0 ? pe[0] : lane == 1 ? pe[1] : lane == 2 ? pe[2] : pe[3]) / s;
        const int slot = atomicAdd(&cnt[ex], 1); rowt[ex * CAP + slot] = row * 4 + lane; rowp[ex * CAP + slot] = p; }
}
__global__ void k_offsets(const int* cnt, int* poff) { if (threadIdx.x == 0) { int o = 0; for (int e = 0; e < NE; ++e) { poff[e] = o; o += (cnt[e] + 255) / 256 * 256; } poff[NE] = o; } }
__global__ __launch_bounds__(256) void k_combine(float* x, const bf16* Y, const float* gate, long gstride) {
    const int lane = threadIdx.x & 63, row = blockIdx.x * 4 + (threadIdx.x >> 6), b = row / SEQ;
#pragma unroll
    for (int j = 0; j < 4; ++j) { const int c4 = lane + 64 * j; f32x4 s = (f32x4){0.f, 0.f, 0.f, 0.f};
#pragma unroll
        for (int k = 0; k < 4; ++k) { const uint2 w = ((const uint2*)(Y + (size_t)(row * 4 + k) * DM))[c4]; s.x += bf2f(w.x & 0xffffu); s.y += bf2f(w.x >> 16); s.z += bf2f(w.y & 0xffffu); s.w += bf2f(w.y >> 16); }
        f32x4* xp = (f32x4*)(x + (size_t)row * DM) + c4; const f32x4 gg = ((const f32x4*)(gate + (size_t)b * gstride))[c4]; *xp = *xp + gg * s; }
}

__global__ void k_kmean(const bf16* K, float* kmean) {
    const int d = threadIdx.x, blk = blockIdx.x & 15, h = (blockIdx.x >> 4) & 15, b = blockIdx.x >> 8; float s = 0.f;
    for (int t = 0; t < 256; ++t) s += bf2f(K[(size_t)(b * SEQ + blk * 256 + t) * DM + h * HD + d]);
    kmean[(size_t)blockIdx.x * HD + d] = s * (1.0f / 256.0f);
}
__global__ __launch_bounds__(256) void k_attn(const bf16* Q, const bf16* K, const bf16* V, const float* kmean, bf16* O) {
    __shared__ float qs[4][HD]; __shared__ float ps[4][1024];
    const int lane = threadIdx.x & 63, w = threadIdx.x >> 6; const int gid = blockIdx.x * 4 + w; const int h = gid & 15, tok = gid >> 4, b = tok / SEQ, pos = tok % SEQ, own = pos >> 8;
    const float qd = bf2f(Q[(size_t)tok * DM + h * HD + lane]); qs[w][lane] = qd;
    const float slope = exp2f(-0.5f * (float)(h + 1));
    float gate = -INFINITY;
    for (int n = 0; n < own; ++n) { const float t = wave_sum(qd * kmean[((size_t)(b * NH + h) * 16 + n) * HD + lane]); if (lane == n) gate = t; }
    int blks[4]; const int nsel = own < 3 ? own : 3;
#pragma unroll
    for (int k = 0; k < 3; ++k) { int idx = -1; if (k < nsel) { const float m = wave_max(gate); const unsigned long long bal = __ballot(gate == m); idx = __ffsll((long long)bal) - 1; if (lane == idx) gate = -INFINITY; } blks[k] = idx; }
    blks[3] = own;
    float sc[4][4]; float mx = -INFINITY;
#pragma unroll
    for (int i = 0; i < 4; ++i) { const int blk = blks[i];
#pragma unroll
        for (int j = 0; j < 4; ++j) { float s = -INFINITY;
            if (blk >= 0) { const int kp = blk * 256 + j * 64 + lane; const u32x4* kr = (const u32x4*)(K + (size_t)(b * SEQ + kp) * DM + h * HD); s = 0.f;
#pragma unroll
                for (int c = 0; c < 8; ++c) { const u32x4 wv = kr[c]; const unsigned ww[4] = {wv.x, wv.y, wv.z, wv.w};
#pragma unroll
                    for (int q = 0; q < 4; ++q) s += qs[w][c * 8 + 2 * q] * bf2f(ww[q] & 0xffffu) + qs[w][c * 8 + 2 * q + 1] * bf2f(ww[q] >> 16); }
                s = s * 0.125f - slope * (float)(pos - kp);
                if (kp > pos) s = -INFINITY; }
            sc[i][j] = s; mx = fmaxf(mx, s); } }
    mx = wave_max(mx); float l = 0.f;
#pragma unroll
    for (int i = 0; i < 4; ++i)
#pragma unroll
        for (int j = 0; j < 4; ++j) { const float p = __expf(sc[i][j] - mx); l += p; ps[w][i * 256 + j * 64 + lane] = p; }
    l = wave_sum(l);
    float o = 0.f;
#pragma unroll
    for (int i = 0; i < 4; ++i) { const int blk = blks[i];
        if (blk >= 0) { const bf16* vb = V + (size_t)(b * SEQ + blk * 256) * DM + h * HD + lane;
            for (int t = 0; t < 256; ++t) o += ps[w][i * 256 + t] * bf2f(vb[(size_t)t * DM]); } }
    O[(size_t)tok * DM + h * HD + lane] = (bf16)f2bf(o / l);
}

extern "C" void kernel_launch(void* const* d_in, const int* in_sizes, int n_in, void* d_out, int out_size, void* d_ws, size_t ws_size, hipStream_t stream) {
    if (n_in != 28 || ws_size < WS_END || out_size != NTOK * DM) { fprintf(stderr, "kernel_launch: unexpected sizes n_in=%d ws=%zu out=%d\n", n_in, ws_size, out_size); return; }
    const float* x = (const float*)d_in[0]; const float* c = (const float*)d_in[1]; const float* ada_w = (const float*)d_in[2]; const float* ada_b = (const float*)d_in[3];
    const float* norm1_g = (const float*)d_in[4]; const float* norm2_g = (const float*)d_in[5]; const float* sgu_w_in = (const float*)d_in[6]; const float* sgu_b_in = (const float*)d_in[7];
    const float* sgu_v_g = (const float*)d_in[8]; const float* sgu_w_s = (const float*)d_in[9]; const float* sgu_b_s = (const float*)d_in[10]; const float* sgu_w_out = (const float*)d_in[11];
    const float* kv_ada_w = (const float*)d_in[12]; const float* kv_ada_b = (const float*)d_in[13]; const float* kv_norm_g = (const float*)d_in[14]; const float* w_kv = (const float*)d_in[15];
    const float* k_norm_g = (const float*)d_in[16]; const float* attn_w_q = (const float*)d_in[17]; const float* q_norm_g = (const float*)d_in[18]; const float* attn_w_o = (const float*)d_in[19];
    const float* w_router = (const float*)d_in[20]; const float* b_router = (const float*)d_in[21]; const float* w_gate = (const float*)d_in[22]; const float* b_gate = (const float*)d_in[23];
    const float* w_up = (const float*)d_in[24]; const float* b_up = (const float*)d_in[25]; const float* w_down = (const float*)d_in[26]; const float* b_down = (const float*)d_in[27];
    char* ws = (char*)d_ws; float* out = (float*)d_out;
    int* cnt = (int*)(ws + WS_CTL); float* mod = (float*)(ws + WS_MOD); float* kvmod = (float*)(ws + WS_KVMOD); float* vrstd = (float*)(ws + WS_VRSTD); float* kmean = (float*)(ws + WS_KMEAN);
    int* rowt = (int*)(ws + WS_ROWT); float* rowp = (float*)(ws + WS_ROWP); int* poff = (int*)(ws + WS_POFF);
    bf16* HA = (bf16*)(ws + WS_HA); bf16* HB = (bf16*)(ws + WS_HB); bf16* U = (bf16*)(ws + WS_U); bf16* V = (bf16*)(ws + WS_V); bf16* Abuf = (bf16*)(ws + WS_A); bf16* Y = (bf16*)(ws + WS_Y);
    bf16* Q = (bf16*)(ws + WS_Q); bf16* Kb = (bf16*)(ws + WS_K); bf16* Vv = (bf16*)(ws + WS_VV); bf16* O = (bf16*)(ws + WS_O);
    hipMemsetAsync(ws + WS_CTL, 0, 1 * MiB, stream);
    k_adaln<<<56, 256, 0, stream>>>(c, ada_w, ada_b, kv_ada_w, kv_ada_b, mod, kvmod);
    { ModP p{norm1_g, mod + 0, mod + 1024, 6144, HA}; k_norm_mod<1><<<2048, 256, 0, stream>>>(x, p, p); }
    gemm_simple<<<dim3(48, 256, 1), 256, 0, stream>>>(ADense{HA, DM}, BDense{sgu_w_in, 6144}, EpiSguIn{sgu_b_in, U, V}, DM);
    k_vrstd<<<NTOK / 4, 256, 0, stream>>>(V, vrstd);
    k_sgu_mix<<<dim3(3, 8, 256), 256, 0, stream>>>(U, V, vrstd, sgu_w_s, sgu_b_s, sgu_v_g);
    gemm_simple<<<dim3(8, 256, 1), 256, 0, stream>>>(ADense{U, DS}, BDense{sgu_w_out, DM}, EpiResid{x, out, mod + 2048, 6144}, DS);
    for (int l = 0; l < 2; ++l) {
        if (l == 1) {
            ModP pk{kv_norm_g, kvmod + 0, kvmod + 1024, 2048, HA}; ModP pq{norm1_g + DM, mod + NB * 6144 + 0, mod + NB * 6144 + 1024, 6144, HB};
            k_norm_mod<2><<<2048, 256, 0, stream>>>(out, pk, pq);
            gemm_simple<<<dim3(16, 256, 1), 256, 0, stream>>>(ADense{HA, DM}, BDense{w_kv, 2048}, EpiHead{k_norm_g, Kb, Vv, DM}, DM);
            k_kmean<<<NB * NH * 16, 64, 0, stream>>>(Kb, kmean);
            gemm_simple<<<dim3(8, 256, 1), 256, 0, stream>>>(ADense{HB, DM}, BDense{attn_w_q, DM}, EpiHead{q_norm_g, Q, Q, DM}, DM);
            k_attn<<<NTOK * NH / 4, 256, 0, stream>>>(Q, Kb, Vv, kmean, O);
            gemm_simple<<<dim3(8, 256, 1), 256, 0, stream>>>(ADense{O, DM}, BDense{attn_w_o, DM}, EpiResid{out, out, mod + NB * 6144 + 2048, 6144}, DM);
        }
        const float* ml = mod + (size_t)l * NB * 6144; int* cl = cnt + l * 64; int* pl = poff + l * 64;
        k_router<<<NTOK / 4, 256, 0, stream>>>(out, norm2_g + l * DM, ml + 3072, ml + 4096, 6144, w_router + (size_t)l * DM * NE, b_router + l * NE, HA, cl, rowt, rowp);
        k_offsets<<<1, 64, 0, stream>>>(cl, pl);
        const size_t wo = (size_t)l * NE * DM * DM, bo = (size_t)l * NE * DM;
        gemm_simple<<<dim3(16, 256, NE), 256, 0, stream>>>(AGather{HA, rowt, cl}, BGateUp{w_gate + wo, w_up + wo}, EpiSwiglu{b_gate + bo, b_up + bo, Abuf, pl, cl}, DM);
        gemm_simple<<<dim3(8, 256, NE), 256, 0, stream>>>(AExpert{Abuf, pl, cl}, BExpert{w_down + wo}, EpiDown{b_down + bo, Y, rowt, rowp, cl}, DM);
        k_combine<<<NTOK / 4, 256, 0, stream>>>(out, Y, ml + 5120, 6144);
    }
}
```

```cpp
#include <hip/hip_runtime.h>
#include <stdint.h>
#include <stdio.h>

#define LAS __attribute__((address_space(3)))
#define GAS __attribute__((address_space(1)))
typedef unsigned short bf16;
typedef short bf16x8 __attribute__((ext_vector_type(8)));
typedef float f32x4 __attribute__((ext_vector_type(4)));
typedef float f32x2 __attribute__((ext_vector_type(2)));
typedef unsigned u32x4 __attribute__((ext_vector_type(4)));
typedef unsigned u32x2 __attribute__((ext_vector_type(2)));
typedef int i32x8 __attribute__((ext_vector_type(8)));
typedef int i32x4 __attribute__((ext_vector_type(4)));
#ifndef MOE1_FP8
#define MOE1_FP8 1
#endif
#ifndef SGU1_FP8
#define SGU1_FP8 0
#endif
#ifndef Y_FP8
#define Y_FP8 1
#endif
#ifndef MOE2_FP8
#define MOE2_FP8 1
#endif

constexpr int NTOK = 32768, DM = 1024, NB = 8, SEQ = 4096, DS = 3072, NE = 32, NH = 16, HD = 64;
constexpr int CAP = 32768;
constexpr float EPS = 1e-6f;
constexpr int NWAVES = 8, NTHREADS = 512;
constexpr float QSCALE = 0.125f * 1.4426950408889634f;

constexpr size_t MiB = 1u << 20;
constexpr size_t WS_CTL = 0, CTL_ZERO_BYTES = 32768;
constexpr size_t WS_KMEAN = 1 * MiB;
constexpr size_t WS_MOD = 2 * MiB;
constexpr size_t WS_KVMOD = WS_MOD + 512 * 1024;
constexpr size_t WS_VPART = 3 * MiB;
constexpr size_t WS_ROWT = 10 * MiB;
constexpr size_t WS_ROWP = 14 * MiB;
constexpr size_t WS_WIN = 18 * MiB, WS_WOUT = 30 * MiB, WS_WKV = 36 * MiB, WS_WQ = 40 * MiB, WS_WO = 42 * MiB;
constexpr size_t WS_W1 = 44 * MiB, WS_W2 = 172 * MiB;
constexpr size_t WS_RWT = 236 * MiB;
constexpr size_t WS_RCB = 238 * MiB;
constexpr size_t WS_HA = 240 * MiB, WS_HB = 304 * MiB;
constexpr size_t WS_X = 368 * MiB;
constexpr size_t WS_U = WS_X, WS_V = WS_X + 192 * MiB;
constexpr size_t WS_A = WS_X, WS_Y = WS_X + 272 * MiB;
constexpr size_t WS_Q = WS_X, WS_K = WS_X + 64 * MiB, WS_VV = WS_X + 128 * MiB, WS_O = WS_X + 192 * MiB;
constexpr size_t WS_TRASH = WS_X + 528 * MiB;
constexpr size_t WS_XS = WS_TRASH + 2 * MiB;
constexpr size_t WS_RW3 = WS_XS + 64 * MiB;
constexpr size_t WS_END = WS_RW3 + 4 * MiB;
constexpr int CW_CNT = 64;
constexpr int CW_BAR = 4096;
constexpr int RING_BYTES = 147456;
constexpr int MISC_OFF = RING_BYTES;
constexpr int LDS_BYTES = RING_BYTES + 512;

__device__ __forceinline__ unsigned f2bf(float f) { unsigned u = __builtin_bit_cast(unsigned, f); return (u + 0x7fffu + ((u >> 16) & 1u)) >> 16; }
__device__ __forceinline__ float bf2f(unsigned b) { return __builtin_bit_cast(float, b << 16); }
__device__ __forceinline__ unsigned cvt_pk_bf16(float lo, float hi) { unsigned r; asm volatile("v_cvt_pk_bf16_f32 %0, %1, %2" : "=v"(r) : "v"(lo), "v"(hi)); return r; }
__device__ __forceinline__ unsigned pk2(float lo, float hi) { return cvt_pk_bf16(lo, hi); }
__device__ __forceinline__ unsigned pk4_fp8(float a, float b, float c, float d) {
    a = __builtin_amdgcn_fmed3f(a, -448.f, 448.f); b = __builtin_amdgcn_fmed3f(b, -448.f, 448.f); c = __builtin_amdgcn_fmed3f(c, -448.f, 448.f); d = __builtin_amdgcn_fmed3f(d, -448.f, 448.f);
    int w = 0; w = __builtin_amdgcn_cvt_pk_fp8_f32(a, b, w, false); w = __builtin_amdgcn_cvt_pk_fp8_f32(c, d, w, true); return (unsigned)w; }
__device__ __forceinline__ unsigned pk4_fp8_nc(float a, float b, float c, float d) { int w = 0; w = __builtin_amdgcn_cvt_pk_fp8_f32(a, b, w, false); w = __builtin_amdgcn_cvt_pk_fp8_f32(c, d, w, true); return (unsigned)w; }
constexpr float F8_SW = 64.f, F8_SH = 8.f, F8_SA = 4.f, F8_SY = 16.f;
__device__ __forceinline__ float wave_sum(float v) {
#pragma unroll
    for (int o = 32; o >= 1; o >>= 1) v += __shfl_xor(v, o);
    return v;
}
__device__ __forceinline__ float wave_max(float v) {
#pragma unroll
    for (int o = 32; o >= 1; o >>= 1) v = fmaxf(v, __shfl_xor(v, o));
    return v;
}
__device__ __forceinline__ float fast_rcp(float x) { return __builtin_amdgcn_rcpf(x); }
__device__ __forceinline__ f32x2 gelu_tanh2(f32x2 x) {
    constexpr float KK = -2.0f * 0.7978845608028654f * 1.4426950408889634f;
    const f32x2 t = (x * x) * (0.044715f * KK) + KK; const f32x2 a = x * t;
    f32x2 e; e.x = __builtin_amdgcn_exp2f(a.x); e.y = __builtin_amdgcn_exp2f(a.y);
    const f32x2 d = e + 1.0f; f32x2 r; r.x = fast_rcp(d.x); r.y = fast_rcp(d.y);
    return x * r;
}

__device__ __forceinline__ int lane_id() { int l = (int)__builtin_amdgcn_mbcnt_hi(~0u, __builtin_amdgcn_mbcnt_lo(~0u, 0u)); asm volatile("" : "+v"(l)); return l; }
__device__ __forceinline__ int my_tid(int wave) { return wave * 64 + lane_id(); }

#define XB_TMO      128
#define XB_XCNT(j)  (256  + 64 * (j))
#define XB_XSUB(j)  (1280 + 64 * (j))
#define XB_XGEN(j)  (2304 + 64 * (j))
#define XB_TOP      3328
#define XB_TOPGEN   3392
#define XCD_BAR_WORDS 3456
#define XB_SPIN_CAP (1u << 18)
__device__ __forceinline__ unsigned xb_ld(unsigned* p)              { return __hip_atomic_load(p, __ATOMIC_RELAXED, __HIP_MEMORY_SCOPE_AGENT); }
__device__ __forceinline__ unsigned xb_add(unsigned* p, unsigned v) { return __hip_atomic_fetch_add(p, v, __ATOMIC_RELAXED, __HIP_MEMORY_SCOPE_AGENT); }
__device__ __forceinline__ unsigned xb_xcc_id() { return (unsigned)__builtin_amdgcn_s_getreg((3 << 11) | 20) & 0xFu; }
#define XB_SPIN(cond, bar) do { unsigned _sp = 0; while (cond) { __builtin_amdgcn_s_sleep(1); \
    if ((++_sp & 255u) == 0u) { if (xb_ld(&(bar)[XB_TMO])) break; if (_sp > XB_SPIN_CAP) { atomicAdd(&(bar)[XB_TMO], 1u); break; } } } } while (0)
struct XcdBarrier { unsigned* bar; unsigned x; volatile LAS unsigned* st; };
__device__ __forceinline__ XcdBarrier xcd_barrier_post(unsigned* bar, volatile LAS unsigned* st, bool t0) {
    XcdBarrier b; b.bar = bar; b.x = xb_xcc_id(); b.st = st;
    if (t0) (void)xb_add(&bar[XB_XCNT(b.x)], 1u);
    return b;
}
__device__ __forceinline__ void xcd_barrier_complete(unsigned* bar, unsigned x, unsigned& nloc, unsigned& nx) {
    const unsigned G = gridDim.x * gridDim.y * gridDim.z;
    unsigned sum, cnt, mine, sp = 0u;
    for (;;) {
        sum = 0u; cnt = 0u; mine = 0u;
#pragma unroll
        for (unsigned j = 0; j < 16; ++j) { const unsigned c = xb_ld(&bar[XB_XCNT(j)]); sum += c; cnt += (c > 0u) ? 1u : 0u; mine = (j == x) ? c : mine; }
        if (sum == G) break;
        __builtin_amdgcn_s_sleep(1);
        if ((++sp & 255u) == 0u) { if (xb_ld(&bar[XB_TMO])) break; if (sp > XB_SPIN_CAP) { atomicAdd(&bar[XB_TMO], 1u); break; } }
    }
    nloc = mine > 0u ? mine : 1u; nx = cnt > 0u ? cnt : 1u;
}
__device__ __forceinline__ void xcd_barrier(const XcdBarrier& b, bool t0) {
    asm volatile("s_waitcnt vmcnt(0)" ::: "memory");
    __syncthreads();
    if (t0) {
        unsigned* bar = b.bar;
        __builtin_amdgcn_s_waitcnt(0);
        unsigned nloc = b.st[0], nx = b.st[1];
        if (nloc == 0u) { xcd_barrier_complete(bar, b.x, nloc, nx); b.st[0] = nloc; b.st[1] = nx; }
        const unsigned old = xb_add(&bar[XB_XSUB(b.x)], 1u);
        const unsigned gen = old / nloc;
        if (old + 1u == (gen + 1u) * nloc) {
            __builtin_amdgcn_fence(__ATOMIC_RELEASE, "agent");
            asm volatile("s_waitcnt vmcnt(0)" ::: "memory");
            const unsigned og = xb_add(&bar[XB_TOP], 1u);
            const unsigned tg = og / nx;
            if (og + 1u == (tg + 1u) * nx) xb_add(&bar[XB_TOPGEN], 1u);
            else XB_SPIN(xb_ld(&bar[XB_TOPGEN]) == tg, bar);
            __builtin_amdgcn_fence(__ATOMIC_ACQUIRE, "agent");
            asm volatile("s_waitcnt vmcnt(0)" ::: "memory");
        } else {
            XB_SPIN(xb_ld(&bar[XB_TOPGEN]) == gen, bar);
            __builtin_amdgcn_fence(__ATOMIC_ACQUIRE, "agent");
            asm volatile("s_waitcnt vmcnt(0)" ::: "memory");
        }
    }
    __syncthreads();
}

namespace pg8 {
constexpr int BM = 256, BK = 64, HALF = 128, HTB = HALF * BK * 2, STAGE_BYTES = 8 * HTB;
__host__ __device__ __forceinline__ int lds_byte(int r, int c) { const int st = (r >> 4) * 2 + (c >> 5), rr = r & 15, cc = c & 31, ob = rr * 64 + cc * 2; return st * 1024 + (ob ^ (((ob >> 9) & 1) << 5)); }
__host__ __device__ __forceinline__ void stage_rc(int b, int& R, int& C) { const int st = b / 1024, sb = b % 1024, swz = sb ^ (((sb >> 9) & 1) << 5); R = (st >> 1) * 16 + swz / 64; C = (st & 1) * 32 + (swz % 64) / 2; }
__host__ __device__ __forceinline__ int perm32(int rho) { const int n = rho >> 4, i = rho & 15; return 8 * (i >> 2) + 4 * n + (i & 3); }

struct Unit { int pm, pn, e, j, nrows; };
typedef f32x4 Acc[2][2][4][2];
struct SideCvt { const float* wg; const float* wu; const float* wd; unsigned char* W1; unsigned char* W2; unsigned char* trash; int c, G;
    static constexpr int NT = 32 * 3 * 256;
    __device__ __forceinline__ void tile(int q, const float*& src, unsigned char*& dst) const {
        const int T = q * G + c; src = wg; dst = trash; if (q < 0 || T >= NT) return;
        const int e = T / 768, r = T % 768, kind = r >> 8, t = r & 255, k0 = 64 * (t >> 4), n0 = 64 * (t & 15);
        const float* w = kind == 0 ? wg : kind == 1 ? wu : wd; src = w + (size_t)e * 1024 * 1024 + (size_t)k0 * 1024 + n0;
        dst = kind == 2 ? W2 + ((size_t)e * 1024 + n0) * 1024 + k0 : W1 + ((size_t)e * 2048 + (n0 >> 7) * 256 + kind * 128 + (n0 & 127)) * 1024 + k0; }
};

template <class P, bool ALIGN_EPI>
__device__ __forceinline__ void gemm_phase(LAS unsigned char* lds, const P& p, int wave_) {
    const int tid = my_tid(wave_), wid = wave_, lane = tid & 63, wr = wid >> 2, wc = wid & 3, fr = lane & 15, fq = lane >> 4;
    constexpr int KB = P::K * P::ESZ  , nt = KB / 128; constexpr bool SIDE = P::SIDE;
    unsigned voffB;
    { int R, C; stage_rc(tid * 16, R, C);
        int Rb = R;
        if (P::BMODE == 1) Rb = (R & ~31) + perm32(R & 31);
        if (P::BMODE == 2) Rb = 64 * ((R >> 5) & 3) + perm32(R & 31);
        voffB = (unsigned)(Rb * KB + C * 2); }
    constexpr unsigned bpiece = (unsigned)(P::BMODE == 2 ? 128 : 64) * KB;
    constexpr unsigned kstep = 128u;
    constexpr unsigned bhalf = (unsigned)(P::BMODE == 2 ? 32 : HALF) * KB;
    const __amdgpu_buffer_rsrc_t rA = __builtin_amdgcn_make_buffer_rsrc((void*)p.a_mat(), 0, 0x7fffffff, 0x00020000), rB = __builtin_amdgcn_make_buffer_rsrc((void*)p.b_mat(), 0, 0x7fffffff, 0x00020000);
    const unsigned ldsw = (unsigned)wid * 1024u;
    const int aoff = lds_byte(wr * 64 + fr, fq * 8), boff = lds_byte(wc * 32 + fr, fq * 8);
    LAS unsigned char* ldsA = lds + aoff; LAS unsigned char* ldsB = lds + 65536 + boff; asm volatile("" : "+v"(ldsA), "+v"(ldsB));
#define PG8_SA(b, h) (((b) * 2 + (h)) * HTB)
#define PG8_SB(b, h) ((4 + (b) * 2 + (h)) * HTB)
#define PG8_STAGE_B(bufoff, soff) do { _Pragma("unroll") for (int _i = 0; _i < 2; ++_i) \
        __builtin_amdgcn_raw_ptr_buffer_load_lds(rB, (LAS unsigned*)(lds + (bufoff) + ldsw + _i * 8192), 16, (int)voffB, (int)((soff) + _i * bpiece), 0, 0); } while (0)
#define PG8_STAGE_A(bufoff, soff, h) do { _Pragma("unroll") for (int _i = 0; _i < 2; ++_i) { \
        if constexpr (P::GATHER) __builtin_amdgcn_raw_ptr_buffer_load_lds(rA, (LAS unsigned*)(lds + (bufoff) + ldsw + _i * 8192), 16, (int)voffA[h][_i], (int)(soff), 0, 0); \
        else __builtin_amdgcn_raw_ptr_buffer_load_lds(rA, (LAS unsigned*)(lds + (bufoff) + ldsw + _i * 8192), 16, (int)voffA[0][0], (int)((soff) + (h) * (128u * KB) + _i * (64u * KB)), 0, 0); } } while (0)
#define PG8_LD8(p_) __builtin_shufflevector(*(const LAS i32x4*)(p_), *(const LAS i32x4*)((p_) + 1024), 0, 1, 2, 3, 4, 5, 6, 7)
#define PG8_LDA(dst, b, h) do { if constexpr (P::FP8) { _Pragma("unroll") for (int m = 0; m < 4; ++m) dst##8[m] = PG8_LD8(ldsA + PG8_SA(b, h) + m * 2048); } \
        else { _Pragma("unroll") for (int m = 0; m < 4; ++m) _Pragma("unroll") for (int k = 0; k < 2; ++k) dst[m][k] = *(const LAS bf16x8*)(ldsA + PG8_SA(b, h) + m * 2048 + k * 1024); } } while (0)
#define PG8_LDB(dst, b, h) do { if constexpr (P::FP8) { _Pragma("unroll") for (int n = 0; n < 2; ++n) dst##8[n] = PG8_LD8(ldsB + (PG8_SB(b, h) - 65536) + n * 2048); } \
        else { _Pragma("unroll") for (int n = 0; n < 2; ++n) _Pragma("unroll") for (int k = 0; k < 2; ++k) dst[n][k] = *(const LAS bf16x8*)(ldsB + (PG8_SB(b, h) - 65536) + n * 2048 + k * 1024); } } while (0)
#define PG8_MMA(ai, bj, At, Bt) do { __builtin_amdgcn_s_setprio(1); \
        if constexpr (P::FP8) { _Pragma("unroll") for (int m = 0; m < 4; ++m) _Pragma("unroll") for (int n = 0; n < 2; ++n) \
            acc[ai][bj][m][n] = __builtin_amdgcn_mfma_scale_f32_16x16x128_f8f6f4(Bt##8[n], At##8[m], acc[ai][bj][m][n], 0, 0, 0, 0x7F7F7F7F, 0, 0x7F7F7F7F); } \
        else { _Pragma("unroll") for (int m = 0; m < 4; ++m) _Pragma("unroll") for (int n = 0; n < 2; ++n) _Pragma("unroll") for (int k = 0; k < 2; ++k) \
            acc[ai][bj][m][n] = __builtin_amdgcn_mfma_f32_16x16x32_bf16(Bt[n][k], At[m][k], acc[ai][bj][m][n], 0, 0, 0); } \
        __builtin_amdgcn_s_setprio(0); } while (0)
#define PG8_WAIT_V(n) asm volatile("s_waitcnt vmcnt(" #n ")" ::: "memory")
#define PG8_WAIT_L(n) asm volatile("s_waitcnt lgkmcnt(" #n ")" ::: "memory")
#define PG8_BAR __builtin_amdgcn_s_barrier()
#define PG8_SCHED __builtin_amdgcn_sched_barrier(0)
    Unit cur, nxt; int ui = 0;
    if (!p.next(0, cur)) return;
    Acc acc;
#pragma unroll
    for (int a = 0; a < 2; ++a)
#pragma unroll
        for (int b = 0; b < 2; ++b)
#pragma unroll
            for (int m = 0; m < 4; ++m)
#pragma unroll
                for (int n = 0; n < 2; ++n) acc[a][b][m][n] = (f32x4){0.f, 0.f, 0.f, 0.f};
    bf16x8 At[4][2], B0[2][2], B1[2][2]; i32x8 At8[4], B08[2], B18[2];
    unsigned voffA[2][2]; p.a_voff(cur, voffA, tid);
    LAS int* idxs = (LAS int*)(lds + STAGE_BYTES) + 4 * tid;
    if constexpr (P::GATHER) { Unit u1; if (p.next(1, u1)) { int tk[2][2]; p.a_idx(u1, tk, tid); idxs[0] = tk[0][0]; idxs[1] = tk[0][1]; idxs[2] = tk[1][0]; idxs[3] = tk[1][1]; } }
    const unsigned sv_dma = ((unsigned)(lane >> 4) + 8u * (unsigned)wid) * 4096u + (unsigned)(lane & 15) * 16u;
    LAS const float* sv_rd = (LAS const float*)(lds + STAGE_BYTES + wid * 2048) + lane;
    const unsigned sv_st = (unsigned)lane * 1024u + 8u * (unsigned)wid;
    int sq = 0; u32x2 sv_pk = {0u, 0u};
#define PG8_SIDE_READ() do { if constexpr (SIDE) { float f_[8]; _Pragma("unroll") for (int j_ = 0; j_ < 8; ++j_) f_[j_] = sv_rd[(j_ >> 2) * 256 + (j_ & 3) * 64] * F8_SW; \
        sv_pk.x = pk4_fp8(f_[0], f_[1], f_[2], f_[3]); sv_pk.y = pk4_fp8(f_[4], f_[5], f_[6], f_[7]); } } while (0)
#define PG8_SIDE_STORE() do { if constexpr (SIDE) { const float* s_; unsigned char* d_; p.side.tile(sq - 1, s_, d_); *(u32x2*)(d_ + sv_st) = sv_pk; } } while (0)
#define PG8_SIDE_DMA() do { if constexpr (SIDE) { const float* s_; unsigned char* d_; p.side.tile(sq, s_, d_); \
        const __amdgpu_buffer_rsrc_t rS_ = __builtin_amdgcn_make_buffer_rsrc((void*)s_, 0, 0x7fffffff, 0x00020000); \
        _Pragma("unroll") for (int _i = 0; _i < 2; ++_i) __builtin_amdgcn_raw_ptr_buffer_load_lds(rS_, (LAS unsigned*)(lds + STAGE_BYTES + wid * 2048 + _i * 1024), 16, (int)sv_dma, _i * 4 * 4096, 0, 2); } } while (0)
    unsigned cA = p.a_off(cur), cB = p.b_off(cur);
#ifndef KLOOP8
#define KLOOP8 0
#endif
#if KLOOP8
    PG8_STAGE_B(PG8_SB(0, 0), cB); PG8_STAGE_A(PG8_SA(0, 0), cA, 0); PG8_STAGE_B(PG8_SB(0, 1), cB + bhalf); PG8_STAGE_A(PG8_SA(0, 1), cA, 1);
    if (wr == 1) PG8_BAR;
    PG8_WAIT_V(4); PG8_BAR;
#else
    PG8_STAGE_B(PG8_SB(0, 0), cB); PG8_STAGE_B(PG8_SB(0, 1), cB + bhalf); PG8_STAGE_A(PG8_SA(0, 0), cA, 0); PG8_STAGE_A(PG8_SA(0, 1), cA, 1);
    if (wr == 1) PG8_BAR;
    PG8_WAIT_V(2); PG8_BAR;
#endif
    PG8_STAGE_B(PG8_SB(1, 0), cB + kstep); PG8_STAGE_A(PG8_SA(1, 0), cA + kstep, 0); PG8_STAGE_B(PG8_SB(1, 1), cB + bhalf + kstep);
    PG8_WAIT_V(6); PG8_BAR;
    for (;;) {
        const bool has_next = p.next(ui + 1, nxt);
        const unsigned nA = has_next ? p.a_off(nxt) : cA, nB = has_next ? p.b_off(nxt) : cB;
#pragma unroll 1
        for (int t = 0; t < nt; t += 2) {
            const bool last = (t == nt - 2);
            const unsigned a1 = cA + (unsigned)(t + 1) * kstep;
            const unsigned a2 = last ? nA : cA + (unsigned)(t + 2) * kstep, b2 = last ? nB : cB + (unsigned)(t + 2) * kstep;
            const unsigned a3 = a2 + kstep, b3 = b2 + kstep;
#if KLOOP8
            PG8_LDB(B0, 0, 0); PG8_SCHED; PG8_LDA(At, 0, 0); PG8_STAGE_A(PG8_SA(1, 1), a1, 1);
            if constexpr (P::GATHER) { if (last && has_next) { const int t_ = my_tid(wave_); LAS const int* ix = (LAS const int*)(lds + STAGE_BYTES) + 4 * t_; const int tk[2][2] = {{ix[0], ix[1]}, {ix[2], ix[3]}}; p.a_voff_from(tk, voffA, t_); } }
            PG8_WAIT_L(8); PG8_BAR; PG8_WAIT_L(0); PG8_MMA(0, 0, At, B0); PG8_BAR; PG8_SCHED;
            PG8_LDB(B1, 0, 1); PG8_STAGE_B(PG8_SB(0, 0), b2);
            PG8_BAR; PG8_WAIT_L(0); PG8_MMA(0, 1, At, B1); PG8_BAR;
            PG8_LDA(At, 0, 1); PG8_STAGE_A(PG8_SA(0, 0), a2, 0);
            PG8_BAR; PG8_WAIT_L(0); PG8_MMA(1, 0, At, B0); PG8_BAR; PG8_SCHED;
            PG8_STAGE_B(PG8_SB(0, 1), b2 + bhalf);
            PG8_WAIT_V(6); PG8_BAR; PG8_MMA(1, 1, At, B1); PG8_BAR;
            PG8_LDB(B0, 1, 0); PG8_SCHED; PG8_LDA(At, 1, 0); PG8_STAGE_A(PG8_SA(0, 1), a2, 1);
            PG8_WAIT_L(8); PG8_BAR; PG8_WAIT_L(0); PG8_MMA(0, 0, At, B0); PG8_BAR; PG8_SCHED;
            PG8_LDB(B1, 1, 1); PG8_STAGE_B(PG8_SB(1, 0), b3);
            PG8_BAR; PG8_WAIT_L(0); PG8_MMA(0, 1, At, B1); PG8_BAR;
            PG8_LDA(At, 1, 1); PG8_STAGE_A(PG8_SA(1, 0), a3, 0);
            PG8_BAR; PG8_WAIT_L(0); PG8_MMA(1, 0, At, B0); PG8_BAR; PG8_SCHED;
            PG8_STAGE_B(PG8_SB(1, 1), b3 + bhalf);
            PG8_WAIT_V(6); PG8_BAR; PG8_MMA(1, 1, At, B1); PG8_BAR;
#else
            PG8_LDB(B0, 0, 0); PG8_LDB(B1, 0, 1); PG8_SCHED; PG8_LDA(At, 0, 0); PG8_STAGE_A(PG8_SA(1, 1), a1, 1); PG8_SIDE_READ();
            if constexpr (P::GATHER) { if (last && has_next) { const int t_ = my_tid(wave_); LAS const int* ix = (LAS const int*)(lds + STAGE_BYTES) + 4 * t_; const int tk[2][2] = {{ix[0], ix[1]}, {ix[2], ix[3]}}; p.a_voff_from(tk, voffA, t_); } }
            PG8_WAIT_V(8); PG8_WAIT_L(0); PG8_BAR; PG8_MMA(0, 0, At, B0); PG8_MMA(0, 1, At, B1); PG8_BAR; PG8_SCHED;
            PG8_LDA(At, 0, 1); PG8_SIDE_STORE(); PG8_STAGE_B(PG8_SB(0, 0), b2); PG8_STAGE_B(PG8_SB(0, 1), b2 + bhalf); PG8_STAGE_A(PG8_SA(0, 0), a2, 0); PG8_SIDE_DMA();
            if constexpr (SIDE) { PG8_WAIT_V(11); } else { PG8_WAIT_V(8); } PG8_WAIT_L(0); PG8_BAR; PG8_MMA(1, 0, At, B0); PG8_MMA(1, 1, At, B1); PG8_BAR; PG8_SCHED;
            PG8_LDB(B0, 1, 0); PG8_LDB(B1, 1, 1); PG8_SCHED; PG8_LDA(At, 1, 0); PG8_STAGE_A(PG8_SA(0, 1), a2, 1);
            if constexpr (SIDE) { PG8_WAIT_V(11); } else { PG8_WAIT_V(8); } PG8_WAIT_L(0); PG8_BAR; PG8_MMA(0, 0, At, B0); PG8_MMA(0, 1, At, B1); PG8_BAR; PG8_SCHED;
            PG8_LDA(At, 1, 1); PG8_STAGE_B(PG8_SB(1, 0), b3); PG8_STAGE_B(PG8_SB(1, 1), b3 + bhalf); PG8_STAGE_A(PG8_SA(1, 0), a3, 0);
            PG8_WAIT_V(8); PG8_WAIT_L(0); PG8_BAR; PG8_MMA(1, 0, At, B0); PG8_MMA(1, 1, At, B1); PG8_BAR; PG8_SCHED;
            if constexpr (SIDE) ++sq;
#endif
        }
        if constexpr (ALIGN_EPI) { if (wr == 0) PG8_BAR; }
        { int tz = my_tid(wave_); asm volatile("" : "+v"(tz));
          const int wz = wave_; int tk2[2][2] = {{0, 0}, {0, 0}}; bool h2 = false;
          if constexpr (P::GATHER) { Unit u2; h2 = has_next && p.next(ui + 2, u2); if (h2) p.a_idx(u2, tk2, tz); }
          p.epi(acc, cur, wz >> 2, wz & 3, tz & 15, (tz >> 4) & 3);
          if constexpr (P::GATHER) { if (h2) { LAS int* ix = (LAS int*)(lds + STAGE_BYTES) + 4 * tz; ix[0] = tk2[0][0]; ix[1] = tk2[0][1]; ix[2] = tk2[1][0]; ix[3] = tk2[1][1]; } } }
        if (!has_next) break;
#pragma unroll
        for (int a = 0; a < 2; ++a)
#pragma unroll
            for (int b = 0; b < 2; ++b)
#pragma unroll
                for (int m = 0; m < 4; ++m)
#pragma unroll
                    for (int n = 0; n < 2; ++n) acc[a][b][m][n] = (f32x4){0.f, 0.f, 0.f, 0.f};
        cur = nxt; cA = nA; cB = nB; ++ui;
        if constexpr (ALIGN_EPI) { if (wr == 1) PG8_BAR; }
    }
    PG8_WAIT_V(0);
    if constexpr (!ALIGN_EPI) { if (wr == 0) PG8_BAR; }
    PG8_BAR;
    if constexpr (SIDE) {
        PG8_SIDE_READ(); PG8_SIDE_STORE();
        for (;;) { const float* s_; unsigned char* d_; if ((long)sq * p.side.G + p.side.c >= SideCvt::NT) break;
            PG8_SIDE_DMA(); PG8_WAIT_V(0); ++sq; PG8_SIDE_READ(); PG8_SIDE_STORE(); PG8_WAIT_L(0); (void)s_; (void)d_; }
        PG8_WAIT_V(0); PG8_BAR; }
#undef PG8_SIDE_READ
#undef PG8_SIDE_STORE
#undef PG8_SIDE_DMA
#undef PG8_SA
#undef PG8_SB
#undef PG8_STAGE_A
#undef PG8_STAGE_B
#undef PG8_LDA
#undef PG8_LDB
#undef PG8_MMA
#undef PG8_LD8
#undef PG8_WAIT_V
#undef PG8_WAIT_L
#undef PG8_BAR
#undef PG8_SCHED
}
struct StaticOrder {
    int nM, nN, nwg, G, c, i0, i1;
    __device__ void init(int M, int N, int G_, int c_) { nM = M / BM; nN = N / BM; nwg = nM * nN; G = G_; c = c_; i0 = 0; i1 = 1 << 30; }
    __device__ bool next(int i, int& pm, int& pn) const {
        i += i0; if (i >= i1) return false;
        const long L = (long)i * G + c; if (L >= nwg) return false;
        int wgid = (int)L; { const int q = nwg / 8, r = nwg % 8, xcd = wgid % 8, off = wgid / 8; wgid = (xcd < r ? xcd * (q + 1) : r * (q + 1) + (xcd - r) * q) + off; }
        const int nig = 8 * nN, gid = wgid / nig, fm = gid * 8, gsz = (nM - fm) < 8 ? (nM - fm) : 8;
        pm = fm + ((wgid % nig) % gsz); pn = (wgid % nig) / gsz; return true;
    }
};
}
using pg8::Unit; using pg8::Acc; using pg8::SideCvt;


struct DenseBase {
    static constexpr bool SIDE = false;
    const char* A; const char* Bt; pg8::StaticOrder S;
    __device__ __forceinline__ bool next(int i, Unit& u) const { u.e = 0; u.j = 0; u.nrows = 256; return S.next(i, u.pm, u.pn); }
};
template <int K_, bool F8_ = false> struct DenseAddr : DenseBase {
    static constexpr int K = K_, ESZ = F8_ ? 1 : 2, KB = K * ESZ; static constexpr bool GATHER = false, FP8 = F8_;
    __device__ __forceinline__ const char* a_mat() const { return A; }
    __device__ __forceinline__ const char* b_mat() const { return Bt; }
    __device__ __forceinline__ unsigned a_off(const Unit& u) const { return (unsigned)u.pm * (256u * KB); }
    __device__ __forceinline__ unsigned b_off(const Unit& u) const { return (unsigned)u.pn * (256u * KB); }
    __device__ __forceinline__ void a_voff(const Unit&, unsigned (&v)[2][2], int tid_) const {
#pragma unroll
        for (int i = 0; i < 2; ++i) { int R, C; pg8::stage_rc(tid_ * 16 + i * 8192, R, C);
#pragma unroll
            for (int h = 0; h < 2; ++h) v[h][i] = (unsigned)((h * 128 + R) * KB + C * 2); } }
};
struct ProbSguIn : DenseAddr<1024, SGU1_FP8 != 0> {
    static constexpr int BMODE = 1;
    const float* bias; bf16* U; bf16* V; float* vpart;
    static constexpr bool SIDE = (MOE1_FP8 != 0) && (MOE2_FP8 != 0) && (SGU1_FP8 == 0); SideCvt side;
    __device__ __forceinline__ void epi(Acc& acc, const Unit& u, int wr, int wc, int fr, int fq) const {
#ifdef EPI2_P2
        _Pragma("unroll 1") for (int rep2 = 0; rep2 < 2; ++rep2) { asm volatile("" ::: "memory");
#else
        {
#endif
        const bool isv = u.pn >= 12; bf16* O = isv ? V : U; const int colt = (isv ? u.pn - 12 : u.pn) * 256 + wc * 32 + 8 * fq, bcol = u.pn * 256 + wc * 32 + 8 * fq;
        f32x4 bv[2][2];
#pragma unroll
        for (int bj = 0; bj < 2; ++bj)
#pragma unroll
            for (int n = 0; n < 2; ++n) bv[bj][n] = *(const f32x4*)(bias + bcol + bj * 128 + 4 * n);
#pragma unroll
        for (int ai = 0; ai < 2; ++ai)
#pragma unroll
            for (int m = 0; m < 4; ++m) { const int row = u.pm * 256 + ai * 128 + wr * 64 + m * 16 + fr; bf16* rowp = O + (size_t)row * DS + colt; float ss = 0.f;
#pragma unroll
                for (int bj = 0; bj < 2; ++bj) { constexpr float SC = SGU1_FP8 ? 1.0f / (F8_SH * F8_SW) : 1.0f; f32x4 v0 = acc[ai][bj][m][0] * SC + bv[bj][0], v1 = acc[ai][bj][m][1] * SC + bv[bj][1];
#pragma unroll
                    for (int j = 0; j < 4; j += 2) { const f32x2 a = gelu_tanh2((f32x2){v0[j], v0[j + 1]}), b = gelu_tanh2((f32x2){v1[j], v1[j + 1]}); v0[j] = a.x; v0[j + 1] = a.y; v1[j] = b.x; v1[j + 1] = b.y;
                        ss += (a.x * a.x + a.y * a.y) + (b.x * b.x + b.y * b.y); }
                    u32x4 w; w.x = cvt_pk_bf16(v0[0], v0[1]); w.y = cvt_pk_bf16(v0[2], v0[3]); w.z = cvt_pk_bf16(v1[0], v1[1]); w.w = cvt_pk_bf16(v1[2], v1[3]);
                    *(u32x4*)(rowp + bj * 128) = w; }
                if (isv) { ss += __shfl_xor(ss, 16); ss += __shfl_xor(ss, 32); if (fq == 0) vpart[(size_t)row * 48 + (u.pn - 12) * 4 + wc] = ss; } }
        }
    }
};
template <int K_, bool XIN16_> struct ProbResid : DenseAddr<K_> {
    static constexpr int BMODE = 1;
    const void* xin; bf16* xout; const float* gate;
    __device__ __forceinline__ void epi(Acc& acc, const Unit& u, int wr, int wc, int fr, int fq) const {
        const int col0 = u.pn * 256 + wc * 32 + 8 * fq; const int b = (u.pm * 256) / SEQ;
        f32x4 gv[2][2];
#pragma unroll
        for (int bj = 0; bj < 2; ++bj)
#pragma unroll
            for (int n = 0; n < 2; ++n) gv[bj][n] = *(const f32x4*)(gate + (size_t)b * 6144 + col0 + bj * 128 + 4 * n);
#pragma unroll
        for (int ai = 0; ai < 2; ++ai)
#pragma unroll
            for (int m = 0; m < 4; ++m) { const size_t off = (size_t)(u.pm * 256 + ai * 128 + wr * 64 + m * 16 + fr) * DM + col0;
#pragma unroll
                for (int bj = 0; bj < 2; ++bj) { f32x4 x0, x1;
                    if constexpr (XIN16_) { const u32x4 w = *(const u32x4*)((const bf16*)xin + off + bj * 128);
                        x0 = (f32x4){bf2f(w.x & 0xffffu), bf2f(w.x >> 16), bf2f(w.y & 0xffffu), bf2f(w.y >> 16)}; x1 = (f32x4){bf2f(w.z & 0xffffu), bf2f(w.z >> 16), bf2f(w.w & 0xffffu), bf2f(w.w >> 16)}; }
                    else { x0 = *(const f32x4*)((const float*)xin + off + bj * 128); x1 = *(const f32x4*)((const float*)xin + off + bj * 128 + 4); }
                    const f32x4 v0 = x0 + gv[bj][0] * acc[ai][bj][m][0], v1 = x1 + gv[bj][1] * acc[ai][bj][m][1];
                    u32x4 o; o.x = cvt_pk_bf16(v0[0], v0[1]); o.y = cvt_pk_bf16(v0[2], v0[3]); o.z = cvt_pk_bf16(v1[0], v1[1]); o.w = cvt_pk_bf16(v1[2], v1[3]);
                    *(u32x4*)(xout + off + bj * 128) = o; } }
    }
};
struct ProbHead : DenseBase {
    static constexpr int K = 1024, ESZ = 2; static constexpr bool GATHER = false, FP8 = false; static constexpr int BMODE = 2;
    const char* A2; const char* Bt2;
    const float* kg; const float* qg; bf16* Kb; bf16* Vb; bf16* Qb; float* kmean;
    __device__ __forceinline__ const char* a_mat() const { return A; }
    __device__ __forceinline__ const char* b_mat() const { return Bt; }
    __device__ __forceinline__ unsigned a_off(const Unit& u) const { return (u.pn >= 8 ? (unsigned)(A2 - A) : 0u) + (unsigned)u.pm * (256u * K * 2); }
    __device__ __forceinline__ unsigned b_off(const Unit& u) const { return u.pn >= 8 ? (unsigned)(Bt2 - Bt) + (unsigned)(u.pn - 8) * (256u * K * 2) : (unsigned)u.pn * (256u * K * 2); }
    __device__ __forceinline__ void a_voff(const Unit&, unsigned (&v)[2][2], int tid_) const {
#pragma unroll
        for (int i = 0; i < 2; ++i) { int R, C; pg8::stage_rc(tid_ * 16 + i * 8192, R, C);
#pragma unroll
            for (int h = 0; h < 2; ++h) v[h][i] = (unsigned)((h * 128 + R) * K + C) * 2u; } }
    __device__ __forceinline__ void epi(Acc& acc, const Unit& u, int wr, int wc, int fr, int fq) const {
        const int kind = u.pn >= 8 ? 2 : (u.pn >= 4 ? 1 : 0);
        const int head = (kind == 0 ? u.pn : kind == 1 ? u.pn - 4 : u.pn - 8) * 4 + wc;
        bf16* O = kind == 0 ? Kb : kind == 1 ? Vb : Qb; const float* g = kind == 2 ? qg : kg;
        f32x4 gv[2][2];
#pragma unroll
        for (int bj = 0; bj < 2; ++bj)
#pragma unroll
            for (int n = 0; n < 2; ++n) gv[bj][n] = *(const f32x4*)(g + 32 * bj + 8 * fq + 4 * n);
        f32x4 ksum[2][2];
#pragma unroll
        for (int bj = 0; bj < 2; ++bj)
#pragma unroll
            for (int n = 0; n < 2; ++n) ksum[bj][n] = (f32x4){0.f, 0.f, 0.f, 0.f};
#pragma unroll
        for (int ai = 0; ai < 2; ++ai)
#pragma unroll
            for (int m = 0; m < 4; ++m) { const int row = u.pm * 256 + ai * 128 + wr * 64 + m * 16 + fr; float rstd = 1.0f;
                if (kind != 1) { float ss = 0.f;
#pragma unroll
                    for (int bj = 0; bj < 2; ++bj)
#pragma unroll
                        for (int n = 0; n < 2; ++n) { const f32x4 x = acc[ai][bj][m][n]; ss += (x[0] * x[0] + x[1] * x[1]) + (x[2] * x[2] + x[3] * x[3]); }
                    ss += __shfl_xor(ss, 16); ss += __shfl_xor(ss, 32); rstd = rsqrtf(ss * (1.0f / HD) + EPS); }
#pragma unroll
                for (int bj = 0; bj < 2; ++bj) { f32x4 v0 = acc[ai][bj][m][0], v1 = acc[ai][bj][m][1];
                    if (kind != 1) { v0 = v0 * rstd * gv[bj][0]; v1 = v1 * rstd * gv[bj][1]; }
                    if (kind == 2) { v0 = v0 * QSCALE; v1 = v1 * QSCALE; }
                    if (kind == 0) { ksum[bj][0] += v0; ksum[bj][1] += v1; }
                    if (kind == 1 && m >= 2) { const float k32 = __builtin_amdgcn_exp2f(32.f * 1.4426950408889634f * __builtin_amdgcn_exp2f(-0.5f * (float)(head + 1))); v0 = v0 * k32; v1 = v1 * k32; }
                    u32x4 w; w.x = cvt_pk_bf16(v0[0], v0[1]); w.y = cvt_pk_bf16(v0[2], v0[3]); w.z = cvt_pk_bf16(v1[0], v1[1]); w.w = cvt_pk_bf16(v1[2], v1[3]);
                    *(u32x4*)(O + (size_t)row * DM + head * HD + 32 * bj + 8 * fq) = w; } }
        if (kind == 0) {
            const int b = (u.pm * 256) / SEQ, blk = u.pm & 15;
#pragma unroll
            for (int bj = 0; bj < 2; ++bj)
#pragma unroll
                for (int n = 0; n < 2; ++n)
#pragma unroll
                    for (int j = 0; j < 4; ++j) { float s = ksum[bj][n][j]; s += __shfl_xor(s, 1); s += __shfl_xor(s, 2); s += __shfl_xor(s, 4); s += __shfl_xor(s, 8);
                        if (fr == 0) atomicAdd(kmean + ((size_t)((b * NH + head) * 16 + blk)) * HD + 32 * bj + 8 * fq + 4 * n + j, s); }
        }
    }
};
struct MoeSched {
    const LAS int* tab; int NN, G, c;
    __device__ __forceinline__ bool next(int i, Unit& u) const {
        const long L = (long)i * G + c; const int T = (int)(L / NN);
        const int tsl = tab[lane_id() & 31];
        const int total = __builtin_amdgcn_readfirstlane(tab[32]); if (T >= total) return false;
        const unsigned long long bal = __ballot(tsl <= T) & 0xffffffffull;
        const int e = __builtin_popcountll(bal) - 1;
        const int ts = __builtin_amdgcn_readlane(tsl, e), cn = __builtin_amdgcn_readfirstlane(tab[33 + e]);
        u.pm = T; u.pn = (int)(L % NN); u.e = e; u.j = T - ts; const int rem = cn - 256 * u.j; u.nrows = rem < 256 ? rem : 256; return true;
    }
};
struct ProbMoe1 {
    static constexpr int K = 1024, BMODE = 1, ESZ = MOE1_FP8 ? 1 : 2, KB = K * ESZ, OKB = K * (MOE2_FP8 ? 1 : 2); static constexpr bool GATHER = true, FP8 = MOE1_FP8 != 0, OUT8 = MOE2_FP8 != 0, SIDE = false;
    MoeSched S; const char* H; const char* W1; const int* rowt; const float* bg; const float* bu; unsigned char* Abuf;
    __device__ __forceinline__ bool next(int i, Unit& u) const { return S.next(i, u); }
    __device__ __forceinline__ const char* a_mat() const { return H; }
    __device__ __forceinline__ const char* b_mat() const { return W1; }
    __device__ __forceinline__ unsigned a_off(const Unit&) const { return 0u; }
    __device__ __forceinline__ unsigned b_off(const Unit& u) const { return ((unsigned)u.e * 2048u + (unsigned)u.pn * 256u) * KB; }
    __device__ __forceinline__ void a_idx(const Unit& u, int (&tk)[2][2], int tid_) const {
#pragma unroll
        for (int i = 0; i < 2; ++i) { int R, C; pg8::stage_rc(tid_ * 16 + i * 8192, R, C);
#pragma unroll
            for (int h = 0; h < 2; ++h) { const int r = h * 128 + R; tk[h][i] = rowt[u.e * CAP + u.j * 256 + (r < u.nrows ? r : 0)]; } } }
    __device__ __forceinline__ void a_voff_from(const int (&tk)[2][2], unsigned (&v)[2][2], int tid_) const {
#pragma unroll
        for (int i = 0; i < 2; ++i) { int R, C; pg8::stage_rc(tid_ * 16 + i * 8192, R, C);
#pragma unroll
            for (int h = 0; h < 2; ++h) v[h][i] = (unsigned)((tk[h][i] >> 2) * KB + C * 2); } }
    __device__ __forceinline__ void a_voff(const Unit& u, unsigned (&v)[2][2], int tid_) const { int tk[2][2]; a_idx(u, tk, tid_); a_voff_from(tk, v, tid_); }
    __device__ __forceinline__ void epi(Acc& acc, const Unit& u, int wr, int wc, int fr, int fq) const {
        const int jo = u.pn * 128 + wc * 32 + 8 * fq;
        f32x4 bgv[2], buv[2];
#pragma unroll
        for (int n = 0; n < 2; ++n) { bgv[n] = *(const f32x4*)(bg + u.e * DM + jo + 4 * n); buv[n] = *(const f32x4*)(bu + u.e * DM + jo + 4 * n); }
#pragma unroll
        for (int ai = 0; ai < 2; ++ai)
#pragma unroll
            for (int m = 0; m < 4; ++m) { const int r = ai * 128 + wr * 64 + m * 16 + fr; f32x4 o[2];
#pragma unroll
                for (int n = 0; n < 2; ++n) { constexpr float SC = FP8 ? 1.0f / (F8_SH * F8_SW) : 1.0f, SO = OUT8 ? F8_SA : 1.0f;
#pragma unroll
                    for (int j = 0; j < 4; j += 2) {
                        const f32x2 ga = (f32x2){acc[ai][0][m][n][j], acc[ai][0][m][n][j + 1]} * SC + (f32x2){bgv[n][j], bgv[n][j + 1]}, ua = (f32x2){acc[ai][1][m][n][j], acc[ai][1][m][n][j + 1]} * SC + (f32x2){buv[n][j], buv[n][j + 1]};
                        f32x2 g, uu; g.x = fminf(ga.x, 7.0f); g.y = fminf(ga.y, 7.0f); uu.x = __builtin_amdgcn_fmed3f(ua.x, -7.0f, 7.0f); uu.y = __builtin_amdgcn_fmed3f(ua.y, -7.0f, 7.0f);
                        const f32x2 t = g * (-1.702f * 1.4426950408889634f); f32x2 e; e.x = __builtin_amdgcn_exp2f(t.x); e.y = __builtin_amdgcn_exp2f(t.y);
                        const f32x2 d = e + 1.0f; f32x2 rr; rr.x = fast_rcp(d.x); rr.y = fast_rcp(d.y);
                        const f32x2 ov = (g * rr) * (uu * SO + SO);
                        o[n][j] = ov.x; o[n][j + 1] = ov.y; } }
                if constexpr (OUT8) { u32x2 w; w.x = pk4_fp8_nc(o[0][0], o[0][1], o[0][2], o[0][3]); w.y = pk4_fp8_nc(o[1][0], o[1][1], o[1][2], o[1][3]);
                    *(u32x2*)(Abuf + (size_t)(u.pm * 256 + r) * OKB + jo) = w; }
                else { u32x4 w; w.x = cvt_pk_bf16(o[0][0], o[0][1]); w.y = cvt_pk_bf16(o[0][2], o[0][3]); w.z = cvt_pk_bf16(o[1][0], o[1][1]); w.w = cvt_pk_bf16(o[1][2], o[1][3]);
                    *(u32x4*)(Abuf + (size_t)(u.pm * 256 + r) * OKB + jo * 2) = w; } }
    }
};
struct ProbMoe2 {
    static constexpr int K = 1024, BMODE = 1, ESZ = MOE2_FP8 ? 1 : 2, KB = K * ESZ; static constexpr bool GATHER = false, FP8 = MOE2_FP8 != 0, SIDE = false;
    MoeSched S; const char* Abuf; const char* W2; const int* rowt; const float* rowp; const float* bd; bf16* Y; bf16* trash;
    __device__ __forceinline__ bool next(int i, Unit& u) const { return S.next(i, u); }
    __device__ __forceinline__ const char* a_mat() const { return Abuf; }
    __device__ __forceinline__ const char* b_mat() const { return W2; }
    __device__ __forceinline__ unsigned a_off(const Unit& u) const { return (unsigned)u.pm * (256u * KB); }
    __device__ __forceinline__ unsigned b_off(const Unit& u) const { return ((unsigned)u.e * 1024u + (unsigned)u.pn * 256u) * KB; }
    __device__ __forceinline__ void a_voff(const Unit&, unsigned (&v)[2][2], int tid_) const {
#pragma unroll
        for (int i = 0; i < 2; ++i) { int R, C; pg8::stage_rc(tid_ * 16 + i * 8192, R, C);
#pragma unroll
            for (int h = 0; h < 2; ++h) v[h][i] = (unsigned)((h * 128 + R) * KB + C * 2); } }
    __device__ __forceinline__ void epi(Acc& acc, const Unit& u, int wr, int wc, int fr, int fq) const {
        const int col0 = u.pn * 256 + wc * 32 + 8 * fq;
        f32x4 bv[2][2];
#pragma unroll
        for (int bj = 0; bj < 2; ++bj)
#pragma unroll
            for (int n = 0; n < 2; ++n) bv[bj][n] = *(const f32x4*)(bd + u.e * DM + col0 + bj * 128 + 4 * n);
        int tk[2][4]; float pr[2][4];
#pragma unroll
        for (int ai = 0; ai < 2; ++ai)
#pragma unroll
            for (int m = 0; m < 4; ++m) { const int r = ai * 128 + wr * 64 + m * 16 + fr; const int slot = u.e * CAP + u.j * 256 + (r < u.nrows ? r : 0); tk[ai][m] = rowt[slot]; pr[ai][m] = rowp[slot]; }
#pragma unroll
        for (int ai = 0; ai < 2; ++ai)
#pragma unroll
            for (int m = 0; m < 4; ++m) { const int r = ai * 128 + wr * 64 + m * 16 + fr;
                const bool valid = r < u.nrows; const int tokk = tk[ai][m]; const float pp = pr[ai][m];
                constexpr int YES = Y_FP8 ? 1 : 2; unsigned char* dst = valid ? (unsigned char*)Y + (size_t)tokk * DM * YES : (unsigned char*)trash;
#pragma unroll
                for (int bj = 0; bj < 2; ++bj) { constexpr float SC = FP8 ? 1.0f / (F8_SA * F8_SW) : 1.0f; const float ps = Y_FP8 ? pp * F8_SY : pp;
                    f32x4 v0, v1;
#pragma unroll
                    for (int j = 0; j < 4; j += 2) { const f32x2 a0 = ((f32x2){acc[ai][bj][m][0][j], acc[ai][bj][m][0][j + 1]} * SC + (f32x2){bv[bj][0][j], bv[bj][0][j + 1]}) * ps, a1 = ((f32x2){acc[ai][bj][m][1][j], acc[ai][bj][m][1][j + 1]} * SC + (f32x2){bv[bj][1][j], bv[bj][1][j + 1]}) * ps;
                        v0[j] = a0.x; v0[j + 1] = a0.y; v1[j] = a1.x; v1[j + 1] = a1.y; }
                    if constexpr (Y_FP8 != 0) { u32x2 w; w.x = pk4_fp8(v0[0], v0[1], v0[2], v0[3]); w.y = pk4_fp8(v1[0], v1[1], v1[2], v1[3]); *(u32x2*)(dst + col0 + bj * 128) = w; }
                    else { u32x4 w; w.x = cvt_pk_bf16(v0[0], v0[1]); w.y = cvt_pk_bf16(v0[2], v0[3]); w.z = cvt_pk_bf16(v1[0], v1[1]); w.w = cvt_pk_bf16(v1[2], v1[3]);
                        *(u32x4*)(dst + (col0 + bj * 128) * 2) = w; } } }
    }
};

#define SBAR() __builtin_amdgcn_sched_barrier(0)
namespace attn_body {
using bf16=unsigned short;
using bf16x8=__attribute__((ext_vector_type(8)))short;
using s16x4=__attribute__((ext_vector_type(4)))short;
using f32x16=__attribute__((ext_vector_type(16)))float;
using u32x4=__attribute__((ext_vector_type(4)))unsigned;
constexpr int BATCH=8,NHEAD=16,SEQ=4096,D=64,DM=NHEAD*D;
constexpr int NW=8,QBLK=32,QB=QBLK*NW,KVBLK=64,NQB=SEQ/QB;
constexpr int ATTN_PITCH=DM, ATTN_UNIT_ROWS=QB;
__device__ __forceinline__ int crow(int r,int hi){return (r&3)+8*(r>>2)+4*hi;}
#define SBAR() __builtin_amdgcn_sched_barrier(0)
__device__ __forceinline__ void cmask(f32x16&p0,f32x16&p1,int jb,int qrel,int hi){
  const float NEG=-INFINITY; int kb=64*jb+4*hi;
  #pragma unroll
  for(int r=0;r<16;++r){int kv=kb+(r&3)+8*(r>>2); if(kv>qrel)p0[r]=NEG; if(kv+32>qrel)p1[r]=NEG;}
}

constexpr int NSLOT=3, SLOTB=8192;
constexpr int LDS_K=0, LDS_V=NSLOT*SLOTB, LDS_WS=2*NSLOT*SLOTB, LDS_OST=LDS_WS+NW*64*4, LDS_KMS=LDS_OST+NW*4096, LDS_BYTES=LDS_KMS+4096;
constexpr float C2=0.125f*1.4426950408889634f;
__device__ __forceinline__ void glds16(const void*gsrc,unsigned lds_dst){unsigned keep;
  asm volatile("s_mov_b32 %0, m0\n\ts_mov_b32 m0, %2\n\ts_nop 0\n\tglobal_load_lds_dwordx4 %1, off\n\ts_mov_b32 m0, %0":"=&s"(keep):"v"(gsrc),"s"(lds_dst):"memory");}
__device__ __forceinline__ float max3f(float a,float b,float c){float r;asm("v_max3_f32 %0, %1, %2, %3":"=v"(r):"v"(a),"v"(b),"v"(c));return r;}
__device__ __forceinline__ float max2f(float a,float b){float r;asm("v_max_f32_e32 %0, %1, %2":"=v"(r):"v"(a),"v"(b));return r;}
__device__ __forceinline__ float fadd_s(float a,float b){float r;asm("v_add_f32_e32 %0, %1, %2":"=v"(r):"v"(a),"v"(b));return r;}
__device__ __forceinline__ float fsub_s(float a,float b){float r;asm("v_sub_f32_e32 %0, %1, %2":"=v"(r):"v"(a),"v"(b));return r;}
typedef float f32x2_t __attribute__((ext_vector_type(2))); typedef float f32x4_t __attribute__((ext_vector_type(4))); constexpr float MFIX=8.0f; typedef __bf16 bf16x2_t __attribute__((ext_vector_type(2)));
__device__ __forceinline__ unsigned cvtpk_s(float lo,float hi){f32x2_t v={lo,hi};bf16x2_t b=__builtin_convertvector(v,bf16x2_t);return __builtin_bit_cast(unsigned,b);}
#define WAIT_BAR(N) asm volatile("s_waitcnt vmcnt(" #N ") lgkmcnt(0)\n\ts_barrier":::"memory")

__device__ __forceinline__ void qkt(f32x16&p0,f32x16&p1,const char*Kslot,const bf16x8*qr,const f32x16&cin,int r32,int hi){
  const char*kb=Kslot+hi*1024+r32*16;
  #pragma unroll
  for(int d0=0;d0<4;++d0){
    const bf16x8 b0=*reinterpret_cast<const bf16x8*>(kb+d0*2048);
    const bf16x8 b1=*reinterpret_cast<const bf16x8*>(kb+d0*2048+512);
    if(d0==0){p0=__builtin_amdgcn_mfma_f32_32x32x16_bf16(b0,qr[0],cin,0,0,0);p1=__builtin_amdgcn_mfma_f32_32x32x16_bf16(b1,qr[0],cin,0,0,0);}
    else{p0=__builtin_amdgcn_mfma_f32_32x32x16_bf16(b0,qr[d0],p0,0,0,0);p1=__builtin_amdgcn_mfma_f32_32x32x16_bf16(b1,qr[d0],p1,0,0,0);}}
}
typedef __attribute__((address_space(3))) const char* lds_cptr;
typedef short v4i16_t __attribute__((ext_vector_type(4)));
__device__ __forceinline__ void kload8(bf16x8*kf,lds_cptr kp){
  kf[0]=*(const __attribute__((address_space(3))) bf16x8*)(kp);      kf[1]=*(const __attribute__((address_space(3))) bf16x8*)(kp+512);
  kf[2]=*(const __attribute__((address_space(3))) bf16x8*)(kp+2048); kf[3]=*(const __attribute__((address_space(3))) bf16x8*)(kp+2560);
  kf[4]=*(const __attribute__((address_space(3))) bf16x8*)(kp+4096); kf[5]=*(const __attribute__((address_space(3))) bf16x8*)(kp+4608);
  kf[6]=*(const __attribute__((address_space(3))) bf16x8*)(kp+6144); kf[7]=*(const __attribute__((address_space(3))) bf16x8*)(kp+6656);
}
__device__ __forceinline__ void kload2(bf16x8*kf,lds_cptr kp,int j){ kf[2*j]=*(const __attribute__((address_space(3))) bf16x8*)(kp+j*2048); kf[2*j+1]=*(const __attribute__((address_space(3))) bf16x8*)(kp+j*2048+512); }
__device__ __forceinline__ s16x4 vtr(lds_cptr p){ return __builtin_bit_cast(s16x4,__builtin_amdgcn_ds_read_tr16_b64_v4i16((__attribute__((address_space(3))) v4i16_t*)p)); }
__device__ __forceinline__ float rowmax(const f32x16&p0,const f32x16&p1){
  float a=max3f(p0[0],p0[1],p1[0]),b=max3f(p0[2],p0[3],p1[1]);a=max3f(a,p1[2],p1[3]);
  #pragma unroll
  for(int r=4;r<16;r+=4){a=max3f(a,p0[r],p0[r+1]);b=max3f(b,p0[r+2],p0[r+3]);a=max3f(a,p1[r],p1[r+1]);b=max3f(b,p1[r+2],p1[r+3]);}
  const float m=max2f(a,b);
  auto rr=__builtin_amdgcn_permlane32_swap(__float_as_uint(m),__float_as_uint(m),false,false);
  return max2f(__uint_as_float(rr[0]),__uint_as_float(rr[1]));
}
__device__ __forceinline__ void pv(f32x16*o,int vb,bf16x8 pa0,bf16x8 pa1,bf16x8 pa2,bf16x8 pa3){
  #pragma unroll
  for(int d0=0;d0<2;++d0){s16x4 lo[4],hi[4];
    #pragma unroll
    for(int ks=0;ks<4;++ks){
      asm volatile("ds_read_b64_tr_b16 %0,%1 offset:%c2":"=&v"(lo[ks]):"v"(vb),"i"(d0*4096+ks*1024):"memory");
      asm volatile("ds_read_b64_tr_b16 %0,%1 offset:%c2":"=&v"(hi[ks]):"v"(vb),"i"(d0*4096+ks*1024+512):"memory");}
    asm volatile("s_waitcnt lgkmcnt(0)":::"memory");SBAR();
    #define PK(k) (bf16x8){lo[k][0],lo[k][1],lo[k][2],lo[k][3],hi[k][0],hi[k][1],hi[k][2],hi[k][3]}
    o[d0]=__builtin_amdgcn_mfma_f32_32x32x16_bf16(pa0,PK(0),o[d0],0,0,0);
    o[d0]=__builtin_amdgcn_mfma_f32_32x32x16_bf16(pa1,PK(1),o[d0],0,0,0);
    o[d0]=__builtin_amdgcn_mfma_f32_32x32x16_bf16(pa2,PK(2),o[d0],0,0,0);
    o[d0]=__builtin_amdgcn_mfma_f32_32x32x16_bf16(pa3,PK(3),o[d0],0,0,0);
    #undef PK
  }
}

#ifndef ATTN_STORE16
#define ATTN_STORE16(p,v) (*(u32x4*)(p)=(v))
#endif
__device__ __forceinline__ void attn_preload(int b,int h,int qb,const bf16*Q,const float*kms,bf16x8(&qr)[4],f32x2_t&kmv,int wave_){
  int tzp=my_tid(wave_); asm volatile("":"+v"(tzp)); const int ln=tzp&63,r32=ln&31,hi=ln>>5;
  const bf16*Qw=Q+((long)b*SEQ+qb*QB+wave_*QBLK)*DM+h*D;
  #pragma unroll
  for(int d0=0;d0<4;++d0)qr[d0]=*reinterpret_cast<const bf16x8*>(&Qw[(long)r32*DM+d0*16+hi*8]);
  kmv=*(const f32x2_t*)(kms+tzp*2);
}
__device__ __forceinline__ void attn_unit(int b,int h,int qb,const bf16*Q,const bf16*__restrict__ K,const bf16*__restrict__ V,bf16*O,char*shm,int wave_,bf16x8(&qr)[4],f32x2_t&kmv,int nb,int nh,int nqb,const float*nkms){
  int tid=my_tid(wave_); asm volatile("":"+v"(tid));
  const int lane=tid&63,r32=lane&31,hi=lane>>5; const int wid=wave_;
  const long rowbase=(long)b*SEQ; const int q0=qb*QB;
  const bf16*Qw=Q+(rowbase+q0+wid*QBLK)*DM+h*D;
  const bf16*Kh=K+rowbase*DM+h*D,*Vh=V+rowbase*DM+h*D;
  const unsigned lds0=(unsigned)(uintptr_t)shm;
  float*wsf=(float*)(shm+LDS_WS)+wid*64;
  const bf16*ksrc=Kh+(long)lane*DM+wid*8;
  const bf16*vsrc=Vh+(long)(16*(wid&3)+(lane>>2))*DM+(wid>>2)*32+(lane&3)*8;
  const unsigned kdst=lds0+LDS_K+wid*1024, vdst=lds0+LDS_V+wid*1024;
  #define DMA_K(t,slot) glds16(ksrc+(long)(t)*KVBLK*DM,(unsigned)__builtin_amdgcn_readfirstlane(kdst+(slot)))
  #define DMA_V(t,slot) glds16(vsrc+(long)(t)*KVBLK*DM,(unsigned)__builtin_amdgcn_readfirstlane(vdst+(slot)))
  const char*Kbase=shm+LDS_K; bf16x8 kf[8];
  const lds_cptr shm3=(lds_cptr)shm; const lds_cptr kp0=shm3+LDS_K+hi*1024+r32*16; const lds_cptr vp0=shm3+LDS_V+((lane>>4)&1)*32+(lane&3)*8+(4*hi+((lane&15)>>2))*64;
  const int NT=(q0+QB)/KVBLK;
  float l_reg=0.f;f32x16 o[2];f32x16 cin;
  const int qrel=wid*QBLK+r32;
  { const int t8=tid; *(f32x2_t*)(shm+LDS_KMS+t8*8)=kmv; }
  asm volatile("" : "+v"(qr[0]),"+v"(qr[1]),"+v"(qr[2]),"+v"(qr[3]));
  int selmask=1<<qb;
  DMA_K(0,0);DMA_V(0,0);DMA_K(1,SLOTB);DMA_K(2,2*SLOTB);
  asm volatile("s_waitcnt lgkmcnt(0)\n\ts_barrier":::"memory");
  { float v1=-INFINITY,v2=-INFINITY,v3=-INFINITY; int i1=-1,i2=-1,i3=-1; float qf[4][8];
    _Pragma("unroll") for(int d0=0;d0<4;++d0) _Pragma("unroll") for(int j=0;j<8;++j) qf[d0][j]=__builtin_bit_cast(float,((unsigned)(unsigned short)qr[d0][j])<<16);
    for(int n=0;n<qb;++n){ const f32x4_t*kp=(const f32x4_t*)(shm+LDS_KMS+(n*64+8*hi)*4); float g=0.f;
      _Pragma("unroll") for(int d0=0;d0<4;++d0){ const f32x4_t a=kp[4*d0],c=kp[4*d0+1]; g+=qf[d0][0]*a[0]+qf[d0][1]*a[1]+qf[d0][2]*a[2]+qf[d0][3]*a[3]+qf[d0][4]*c[0]+qf[d0][5]*c[1]+qf[d0][6]*c[2]+qf[d0][7]*c[3]; }
      { auto rr=__builtin_amdgcn_permlane32_swap(__float_as_uint(g),__float_as_uint(g),false,false); g=__uint_as_float(rr[0])+__uint_as_float(rr[1]); }
      const bool a1=g>v1,a2=g>v2,a3=g>v3;
      v3=a2?v2:(a3?g:v3); i3=a2?i2:(a3?n:i3);
      v2=a1?v1:(a2?g:v2); i2=a1?i1:(a2?n:i2);
      v1=a1?g:v1;         i1=a1?n:i1; }
    if(i1>=0)selmask|=1<<i1; if(i2>=0)selmask|=1<<i2; if(i3>=0)selmask|=1<<i3; }
  WAIT_BAR(3);
  const float c2=__builtin_amdgcn_exp2f(-0.5f*(float)(h+1))*1.4426950408889634f; const int qk=q0+qrel-4*hi;
  const float k32=__builtin_amdgcn_exp2f(32.f*c2);
  #define CINIT(t_) do{ const int tt_=(t_); const float base_=((selmask>>(tt_>>2))&1)?__builtin_fmaf(-c2,(float)(qk-64*tt_),-MFIX):-1e30f; \
    _Pragma("unroll") for(int r=0;r<16;++r)cin[r]=__builtin_fmaf(c2,(float)((r&3)+8*(r>>2)),base_); asm volatile("":"+v"(cin)); }while(0)
  #define CNEXT(t_) do{ const int tn_=(t_); if((tn_&3)==0){ CINIT(tn_); } else { const float st_=64.f*c2; _Pragma("unroll") for(int r=0;r<16;++r)cin[r]+=st_; asm volatile("":"+v"(cin)); } }while(0)
  CINIT(0); o[0]=f32x16{};o[1]=f32x16{};
  #define CMASK(P0,P1,t) do{int jb_=(t)-(NT-4); if(jb_>=0)cmask(P0,P1,jb_,qrel,hi);}while(0)
  #define START(P0,P1) do{ CINIT(1); _Pragma("unroll") for(int r=0;r<16;++r)P0[r]=__builtin_amdgcn_exp2f(P0[r]); }while(0)
  #define RESC() do{}while(0)
  f32x16 pA0,pA1,pB0,pB1;
  int sl_prev=0,sl_cur=0,sl_next=SLOTB;
  #define ROT() do{sl_prev=sl_cur;sl_cur=sl_next;sl_next=(sl_next==(NSLOT-1)*SLOTB)?0:sl_next+SLOTB;}while(0)
  qkt(pA0,pA1,Kbase,qr,cin,r32,hi);asm volatile("s_nop 15\n\ts_nop 7":"+v"(pA0),"+v"(pA1));CMASK(pA0,pA1,0);
  START(pA0,pA1);
  _Pragma("unroll") for(int r=0;r<16;++r)pA1[r]=__builtin_amdgcn_exp2f(pA1[r]);
  WAIT_BAR(0);
  DMA_K(3,0);DMA_V(1,SLOTB);
  ROT();
  kload8(kf,kp0+sl_cur);
  WAIT_BAR(2);
  s16x4 vlo[8],vhi[8]; u32x4 pw0,pw1,pw2,pw3;
  #define PKW(P,B) cvtpk_s(P[B],P[B+1])
  #define PAF(k) __builtin_bit_cast(bf16x8,pw##k)
  #define VFR(i) (bf16x8){vlo[i][0],vlo[i][1],vlo[i][2],vlo[i][3],vhi[i][0],vhi[i][1],vhi[i][2],vhi[i][3]}
  #define PIN(x) asm volatile("":"+v"(x))
  #define MX3(a,b,c) __builtin_fmaxf(__builtin_fmaxf((a),(b)),(c))
  #define GAPA(MF,A0,A1,A2,A3,W0,W1,PW) do{ MF; sacc+=A0; sacc+=A1; sacc+=A2; sacc+=A3; PIN(sacc); W0; W1; PIN(PW); SBAR(); }while(0)
  #define GAPA2(MF,A0,A1,B0,B1,W0,W1,PW) do{ MF; sacc+=A0; sacc+=A1; sacc1=B0+B1; PIN(sacc); PIN(sacc1); W0; W1; PIN(PW); SBAR(); }while(0)
  #define GAPA1(MF,A0,A1,A2,A3,W0,W1,PW) do{ MF; sacc1+=A0; sacc1+=A1; sacc1+=A2; sacc1+=A3; PIN(sacc1); W0; W1; PIN(PW); SBAR(); }while(0)
  #define EX(v) __builtin_amdgcn_exp2f(v)
  #define GAPB(MF,X,B) do{ MF; X[B]=EX(X[B]); X[B+1]=EX(X[B+1]); X[B+2]=EX(X[B+2]); X[B+3]=EX(X[B+3]); PIN(X); SBAR(); }while(0)
  #define GAPBC(MF,X,B) GAPB(MF,X,B)
  #define VRD(i) do{ vlo[i]=vtr(vp_+(((i)>>2)*4096+((i)&3)*1024)); vhi[i]=vtr(vp_+(((i)>>2)*4096+((i)&3)*1024+512)); }while(0)
  #define KRD(G,j) do{ if(G){ kload2(kf,kp0+sl_next,j); SBAR(); } }while(0)
  #define STEP(C0,C1,P0,P1,t,GK,GV,GL) do{ SBAR(); \
    const lds_cptr vp_=vp0+sl_prev; \
    VRD(0); SBAR(); float sacc=(P0[0]+P0[1]),sacc1; \
    GAPA(C0=__builtin_amdgcn_mfma_f32_32x32x16_bf16(kf[0],qr[0],cin,0,0,0), P0[2],P0[3],P0[4],P0[5],     pw0[0]=PKW(P0,0), pw0[1]=PKW(P0,2), pw0); \
    VRD(4); SBAR(); GAPA(C1=__builtin_amdgcn_mfma_f32_32x32x16_bf16(kf[1],qr[0],cin,0,0,0), P0[6],P0[7],P0[8],P0[9],     pw0[2]=PKW(P0,4), pw0[3]=PKW(P0,6), pw0); \
    VRD(1); SBAR(); GAPA(C0=__builtin_amdgcn_mfma_f32_32x32x16_bf16(kf[2],qr[1],C0,0,0,0),   P0[10],P0[11],P0[12],P0[13], pw1[0]=PKW(P0,8), pw1[1]=PKW(P0,10), pw1); \
    VRD(5); SBAR(); GAPA2(C1=__builtin_amdgcn_mfma_f32_32x32x16_bf16(kf[3],qr[1],C1,0,0,0),  P0[14],P0[15],P1[0],P1[1],   pw1[2]=PKW(P0,12),pw1[3]=PKW(P0,14), pw1); \
    VRD(2); SBAR(); GAPA1(C0=__builtin_amdgcn_mfma_f32_32x32x16_bf16(kf[4],qr[2],C0,0,0,0),  P1[2],P1[3],P1[4],P1[5],     pw2[0]=PKW(P1,0), pw2[1]=PKW(P1,2), pw2); \
    VRD(6); SBAR(); GAPA1(C1=__builtin_amdgcn_mfma_f32_32x32x16_bf16(kf[5],qr[2],C1,0,0,0),  P1[6],P1[7],P1[8],P1[9],     pw2[2]=PKW(P1,4), pw2[3]=PKW(P1,6), pw2); \
    VRD(3); SBAR(); GAPA1(C0=__builtin_amdgcn_mfma_f32_32x32x16_bf16(kf[6],qr[3],C0,0,0,0),  P1[10],P1[11],P1[12],P1[13], pw3[0]=PKW(P1,8), pw3[1]=PKW(P1,10), pw3); \
    VRD(7); SBAR(); GAPA1(C1=__builtin_amdgcn_mfma_f32_32x32x16_bf16(kf[7],qr[3],C1,0,0,0),  P1[14],P1[15],0.f,0.f,       pw3[2]=PKW(P1,12),pw3[3]=PKW(P1,14), pw3); \
    l_reg+=sacc; l_reg=__builtin_fmaf(k32,sacc1,l_reg); \
    if(GK){DMA_K((t)+3,sl_cur);} if(GV){DMA_V((t)+1,sl_next);} \
    CMASK(C0,C1,t); \
    CNEXT((t)+1); \
    SBAR(); \
    GAPB(o[0]=__builtin_amdgcn_mfma_f32_32x32x16_bf16(PAF(0),VFR(0),o[0],0,0,0), C0,0); \
    GAPB(o[1]=__builtin_amdgcn_mfma_f32_32x32x16_bf16(PAF(0),VFR(4),o[1],0,0,0), C0,4); \
    KRD(GL,0); GAPB(o[0]=__builtin_amdgcn_mfma_f32_32x32x16_bf16(PAF(1),VFR(1),o[0],0,0,0), C0,8); \
    KRD(GL,1); GAPB(o[1]=__builtin_amdgcn_mfma_f32_32x32x16_bf16(PAF(1),VFR(5),o[1],0,0,0), C0,12); \
    KRD(GL,2); GAPBC(o[0]=__builtin_amdgcn_mfma_f32_32x32x16_bf16(PAF(2),VFR(2),o[0],0,0,0), C1,0); \
    KRD(GL,3); GAPBC(o[1]=__builtin_amdgcn_mfma_f32_32x32x16_bf16(PAF(2),VFR(6),o[1],0,0,0), C1,4); \
    GAPBC(o[0]=__builtin_amdgcn_mfma_f32_32x32x16_bf16(PAF(3),VFR(3),o[0],0,0,0), C1,8); \
    GAPBC(o[1]=__builtin_amdgcn_mfma_f32_32x32x16_bf16(PAF(3),VFR(7),o[1],0,0,0), C1,12); \
    }while(0)
  int t=1;
  #undef CMASK
  #define CMASK(P0,P1,t) do{}while(0)
  for(;t+5<NT;t+=2){
    STEP(pB0,pB1,pA0,pA1,t,true,true,true);     WAIT_BAR(2); RESC(); ROT();
    STEP(pA0,pA1,pB0,pB1,t+1,true,true,true);   WAIT_BAR(2); RESC(); ROT();
  }
  #undef CMASK
  int tzb=my_tid(wave_); asm volatile("":"+v"(tzb)); const int hib=(tzb>>5)&1, qrelb=(tzb>>6)*QBLK+(tzb&31);
  #define CMASK(P0,P1,t) do{int jb_=(t)-(NT-4); if(jb_>=0)cmask(P0,P1,jb_,qrelb,hib);}while(0)
  #define ENDW(tt) do{ if((tt)+3<NT){WAIT_BAR(2);} else if((tt)+2<NT){WAIT_BAR(1);} else {WAIT_BAR(0);} }while(0)
  for(;t+1<NT;t+=2){
    STEP(pB0,pB1,pA0,pA1,t,(t+3<NT),(t+1<NT),(t+1<NT));       ENDW(t);   RESC(); ROT();
    STEP(pA0,pA1,pB0,pB1,t+1,(t+4<NT),(t+2<NT),(t+2<NT));     ENDW(t+1); RESC(); ROT();
  }
  STEP(pB0,pB1,pA0,pA1,NT-1,false,false,false); RESC();
  attn_preload(nb,nh,nqb,Q,nkms,qr,kmv,wave_);
  { float sacc=pB0[0]+pB0[1],sacc1=pB1[0]+pB1[1]; _Pragma("unroll") for(int r=2;r<16;++r)sacc+=pB0[r]; _Pragma("unroll") for(int r=2;r<16;++r)sacc1+=pB1[r]; l_reg+=sacc; l_reg=__builtin_fmaf(k32,sacc1,l_reg);
    pw0=(u32x4){PKW(pB0,0),PKW(pB0,2),PKW(pB0,4),PKW(pB0,6)};pw1=(u32x4){PKW(pB0,8),PKW(pB0,10),PKW(pB0,12),PKW(pB0,14)};pw2=(u32x4){PKW(pB1,0),PKW(pB1,2),PKW(pB1,4),PKW(pB1,6)};pw3=(u32x4){PKW(pB1,8),PKW(pB1,10),PKW(pB1,12),PKW(pB1,14)};
    int tzd=my_tid(wave_); asm volatile("":"+v"(tzd)); const int ld_=tzd&63; const int vb0=(int)(lds0+LDS_V)+((ld_>>4)&1)*32+(ld_&3)*8+(4*(ld_>>5)+((ld_&15)>>2))*64;
    SBAR(); pv(o,vb0+sl_cur,PAF(0),PAF(1),PAF(2),PAF(3)); }
  #undef PKW
  #undef PAF
  #undef VFR
  #undef PIN
  #undef MX3
  #undef GAPA
  #undef GAPB
  #undef GAPBC
  #undef EX
  #undef VRD
  #undef KRD
  #undef STEP
  #undef ENDW
  int tze=my_tid(wave_); asm volatile("":"+v"(tze));
  { const int lane=tze&63,r32=lane&31,hi=lane>>5; const int wid=wave_; float*wsf=(float*)(shm+LDS_WS)+wid*64;
  {auto rr=__builtin_amdgcn_permlane32_swap(__float_as_uint(l_reg),__float_as_uint(l_reg),false,false);l_reg=__uint_as_float(rr[0])+__uint_as_float(rr[1]);}
  if(hi==0)wsf[32+r32]=l_reg;asm volatile("s_waitcnt lgkmcnt(0)":::"memory");
  float rli[16];
  #pragma unroll
  for(int r=0;r<16;++r)rli[r]=__builtin_amdgcn_rcpf(wsf[32+crow(r,hi)]);
  bf16*Ow=O+(rowbase+q0+wid*QBLK)*DM+h*D;
  { bf16*stg=(bf16*)(shm+LDS_OST)+wid*2048;
    #pragma unroll
    for(int r=0;r<16;++r){const int orow=crow(r,hi);
      #pragma unroll
      for(int d0=0;d0<2;++d0)stg[orow*64+d0*32+r32]=(bf16)::f2bf(o[d0][r]*rli[r]);}
    asm volatile("s_waitcnt lgkmcnt(0)":::"memory");
    #pragma unroll
    for(int i=0;i<4;++i){const int row=i*8+(lane>>3),ch=lane&7; const u32x4 v=*(const u32x4*)(stg+row*64+ch*8); ATTN_STORE16(Ow+(long)row*DM+ch*8,v);} }
  }
  asm volatile("s_waitcnt lgkmcnt(0)\n\ts_barrier":::"memory");
  #undef DMA_K
  #undef DMA_V
  #undef CMASK
  #undef START
  #undef RESC
  #undef CINIT
  #undef ROT
}
constexpr int ATTN_LDS_BYTES=LDS_BYTES;
struct AttnTensors { const bf16* Q; const bf16* K; const bf16* V; bf16* O; };
struct AttnUnit { int bh; int qb; };
struct StaticOrder {
  int vcu;
  __device__ __forceinline__ explicit StaticOrder(int grid,int block):vcu((block%8)*(grid/8)+block/8){}
  __device__ __forceinline__ bool next(int i,AttnUnit&u)const{ if(i>=8)return false; const int x=vcu>>5,c=vcu&31,g=i>>1,k=c&7; u.bh=x*16+g*4+(c>>3); u.qb=(i&1)?k:15-k; return true; }
};
__device__ __forceinline__ void attn_phase(char*lds,const AttnTensors&T,const float*kmean,const StaticOrder&S,int wave_){
  AttnUnit u;
  bf16x8 qr[4]; f32x2_t kmv; AttnUnit un; if(!S.next(0,u))return; attn_preload(u.bh/NHEAD,u.bh%NHEAD,u.qb,T.Q,kmean+(size_t)u.bh*16*64,qr,kmv,wave_);
  for(int i=0;;++i){ const bool hn=S.next(i+1,un); if(!hn)un=u; attn_unit(u.bh/NHEAD,u.bh%NHEAD,u.qb,T.Q,T.K,T.V,T.O,lds,wave_,qr,kmv,un.bh/NHEAD,un.bh%NHEAD,un.qb,kmean+(size_t)un.bh*16*64); if(!hn)break; u=un; }
}
#undef SBAR
#undef WAIT_BAR
}

struct Frame {
    LAS unsigned char* lds; int tid, lane, wave, vcu, G;
};
__device__ __forceinline__ Frame phase_frame(const Frame& F0) { Frame F = F0; F.tid = my_tid(F0.wave); asm volatile("" : "+v"(F.tid)); F.lane = F.tid & 63; return F; }
#define LDS_WAIT() asm volatile("s_waitcnt lgkmcnt(0)" ::: "memory")

struct CvtItem { const float* src; unsigned char* dst; int N, KB, f8; };
__device__ __forceinline__ void cvt_load(const CvtItem& it, f32x4 (&v)[8], int lane) {
#pragma unroll
    for (int i = 0; i < 8; ++i) v[i] = __builtin_nontemporal_load((const f32x4*)(it.src + (size_t)(8 * i + (lane >> 3)) * it.N + (lane & 7) * 4));
}
__device__ __forceinline__ void cvt_store(const CvtItem& it, const f32x4 (&v)[8], LAS float* scr, int lane) {
#pragma unroll
    for (int i = 0; i < 8; ++i) { LAS float* d = scr + (8 * i + (lane >> 3)) * 33 + (lane & 7) * 4; d[0] = v[i].x; d[1] = v[i].y; d[2] = v[i].z; d[3] = v[i].w; }
    LDS_WAIT(); asm volatile("" ::: "memory");
    const int c = lane & 7;
#pragma unroll
    for (int j = 0; j < 4; ++j) { const int n = (lane >> 3) + 8 * j; const LAS float* s = scr + (8 * c) * 33 + n;
        if (it.f8) { u32x2 o; o.x = pk4_fp8(s[0 * 33] * F8_SW, s[1 * 33] * F8_SW, s[2 * 33] * F8_SW, s[3 * 33] * F8_SW); o.y = pk4_fp8(s[4 * 33] * F8_SW, s[5 * 33] * F8_SW, s[6 * 33] * F8_SW, s[7 * 33] * F8_SW);
            *(u32x2*)(it.dst + (size_t)n * it.KB + 8 * c) = o; }
        else { u32x4 o; o.x = pk2(s[0 * 33], s[1 * 33]); o.y = pk2(s[2 * 33], s[3 * 33]); o.z = pk2(s[4 * 33], s[5 * 33]); o.w = pk2(s[6 * 33], s[7 * 33]);
            *(u32x4*)(it.dst + (size_t)n * it.KB + 16 * c) = o; } }
    LDS_WAIT(); asm volatile("" ::: "memory");
}
__device__ __forceinline__ CvtItem cvt_plain(const float* W, int K, int N, unsigned char* WT, int item, bool f8) {
    const int nblk = N / 32, kb = item / nblk, nb = item % nblk, es = f8 ? 1 : 2; CvtItem it; it.src = W + (size_t)(64 * kb) * N + 32 * nb; it.N = N; it.KB = K * es; it.f8 = f8; it.dst = WT + (size_t)(32 * nb) * it.KB + 64 * kb * es; return it;
}
__device__ __forceinline__ CvtItem cvt_moe(const float* wg, const float* wu, const float* wd, unsigned char* W1, unsigned char* W2, int item) {
    const int e = item / 1536, r = item % 1536, kind = r / 512, t = r % 512, kb = t / 32, nb = t % 32, n0 = 32 * nb; const size_t wo = (size_t)e * DM * DM;
    constexpr int ES1 = MOE1_FP8 ? 1 : 2, ES2 = MOE2_FP8 ? 1 : 2; CvtItem it; it.N = DM;
    if (kind == 2) { it.src = wd + wo + (size_t)(64 * kb) * DM + n0; it.KB = DM * ES2; it.f8 = MOE2_FP8; it.dst = W2 + ((size_t)e * DM + n0) * it.KB + 64 * kb * ES2; }
    else { it.src = (kind ? wu : wg) + wo + (size_t)(64 * kb) * DM + n0; it.KB = DM * ES1; it.f8 = MOE1_FP8; it.dst = W1 + ((size_t)e * 2048 + (n0 >> 7) * 256 + kind * 128 + (n0 & 127)) * it.KB + 64 * kb * ES1; }
    return it;
}
struct ModP { const float* g; const float* shift; const float* scale; bf16* out; };
template <int NOUT> __device__ __forceinline__ void norm_mod_regs(const f32x4 (&v)[4], int b, int lane, const ModP& p0, int bs0, const ModP& p1, int bs1) {
    float ss = 0.f;
#pragma unroll
    for (int j = 0; j < 4; ++j) ss += v[j].x * v[j].x + v[j].y * v[j].y + v[j].z * v[j].z + v[j].w * v[j].w;
    const float rstd = rsqrtf(wave_sum(ss) * (1.0f / DM) + EPS);
#pragma unroll
    for (int o = 0; o < NOUT; ++o) { const ModP& p = o ? p1 : p0; const int bs = o ? bs1 : bs0;
#pragma unroll
        for (int j = 0; j < 4; ++j) { const int c4 = lane + 64 * j; const f32x4 g = ((const f32x4*)p.g)[c4], sh = ((const f32x4*)(p.shift + (size_t)b * bs))[c4], sc = ((const f32x4*)(p.scale + (size_t)b * bs))[c4];
            const f32x4 h = v[j] * rstd * g * (sc + 1.0f) + sh;
            u32x2 w; w.x = pk2(h.x, h.y); w.y = pk2(h.z, h.w); ((u32x2*)p.out)[c4] = w; } }
}

struct Args { const float* in[28]; float* out; unsigned char* ws; int ph_lo, ph_hi; };
__device__ __forceinline__ void cvt_moe_share(const Frame& F0, const Args& args, int layer) {
    const Frame F = phase_frame(F0);
    const int gw = F.vcu * NWAVES + F.wave, NGW = F.G * NWAVES;
    LAS float* scr = (LAS float*)(F.lds + F.wave * 8448);
    const size_t wo = (size_t)layer * NE * DM * DM; unsigned char* ws = args.ws;
    constexpr int NIT = 32 * 1536;
    auto decode = [&](int it) -> CvtItem { return cvt_moe(args.in[22] + wo, args.in[24] + wo, args.in[26] + wo, ws + WS_W1, ws + WS_W2, it); };
    const int n = gw < NIT ? (NIT - gw + NGW - 1) / NGW : 0, n4 = n & ~3;
    if (n4 > 0) { CvtItem c0 = decode(gw), c1 = decode(gw + NGW), c2 = decode(gw + 2 * NGW), c3 = decode(gw + 3 * NGW); f32x4 v0[8], v1[8], v2[8], v3[8];
        cvt_load(c0, v0, F.lane); cvt_load(c1, v1, F.lane); cvt_load(c2, v2, F.lane); cvt_load(c3, v3, F.lane);
#pragma unroll 1
        for (int q = 4; q < n4; q += 4) { const int it = gw + q * NGW;
            cvt_store(c0, v0, scr, F.lane); c0 = decode(it); cvt_load(c0, v0, F.lane); __builtin_amdgcn_sched_barrier(0);
            cvt_store(c1, v1, scr, F.lane); c1 = decode(it + NGW); cvt_load(c1, v1, F.lane); __builtin_amdgcn_sched_barrier(0);
            cvt_store(c2, v2, scr, F.lane); c2 = decode(it + 2 * NGW); cvt_load(c2, v2, F.lane); __builtin_amdgcn_sched_barrier(0);
            cvt_store(c3, v3, scr, F.lane); c3 = decode(it + 3 * NGW); cvt_load(c3, v3, F.lane); __builtin_amdgcn_sched_barrier(0); }
        cvt_store(c0, v0, scr, F.lane); __builtin_amdgcn_sched_barrier(0); cvt_store(c1, v1, scr, F.lane); __builtin_amdgcn_sched_barrier(0); cvt_store(c2, v2, scr, F.lane); __builtin_amdgcn_sched_barrier(0); cvt_store(c3, v3, scr, F.lane); }
    for (int q = n4; q < n; ++q) { const CvtItem c = decode(gw + q * NGW); f32x4 v[8]; cvt_load(c, v, F.lane); cvt_store(c, v, scr, F.lane); }
}
#ifndef ONLY_PHASE
#define ONLY_PHASE -1
#endif
#ifndef PH_MASK
#define PH_MASK 0xffff
#endif
#define CK(k) ((ONLY_PHASE < 0 || ONLY_PHASE == (k)) && ((PH_MASK >> (k)) & 1))
#ifndef DUP_PHASE
#define DUP_PHASE -1
#endif
#define DUP(k) _Pragma("unroll") for (int rep_ = 0; rep_ < (DUP_PHASE == (k) ? 2 : 1); ++rep_)

typedef float f32x16 __attribute__((ext_vector_type(16)));
__device__ __forceinline__ void top4_insert(float v, int i, float (&tv)[4], int (&ti)[4]) {
    const bool a0 = v > tv[0] || (v == tv[0] && i < ti[0]), a1 = v > tv[1] || (v == tv[1] && i < ti[1]), a2 = v > tv[2] || (v == tv[2] && i < ti[2]), a3 = v > tv[3] || (v == tv[3] && i < ti[3]);
    tv[3] = a2 ? tv[2] : (a3 ? v : tv[3]); ti[3] = a2 ? ti[2] : (a3 ? i : ti[3]);
    tv[2] = a1 ? tv[1] : (a2 ? v : tv[2]); ti[2] = a1 ? ti[1] : (a2 ? i : ti[2]);
    tv[1] = a0 ? tv[0] : (a1 ? v : tv[1]); ti[1] = a0 ? ti[0] : (a1 ? i : ti[1]);
    tv[0] = a0 ? v : tv[0];               ti[0] = a0 ? i : ti[0];
}
template <int L> __device__ __forceinline__ void ph_router(const Frame& F0, const Args& args) {
    const Frame F = phase_frame(F0);
    unsigned char* ws = args.ws; const float* ml = (const float*)(ws + WS_MOD) + (size_t)L * NB * 6144; int* cl = (int*)(ws + WS_CTL) + CW_CNT + L * 64;
    int* rowt = (int*)(ws + WS_ROWT); float* rowp = (float*)(ws + WS_ROWP); bf16* HA = (bf16*)(ws + WS_HA); const bf16* xs = (const bf16*)(ws + WS_XS);
    const int lane = F.lane; const int gw = F.vcu * NWAVES + F.wave, NGW = F.G * NWAVES;
    {
        const int T = F.vcu * 4 + (F.wave & 3), kq = F.wave >> 2;
        LAS float* xch = (LAS float*)(F.lds + (F.wave & 3) * 64 * 17 * 4);
        if (F.tid < 8) ((LAS int*)(F.lds + 17920))[256 + F.tid] = 0;
        LAS float* rsx = (LAS float*)(F.lds + 4 * 64 * 17 * 4) + (F.wave & 3) * 32;
        const float* g = args.in[5] + L * DM;
        for (int tile = T; tile < NTOK / 32; tile += F.G * 4) {
            const int tok0 = tile * 32, b = tok0 / SEQ, j = lane & 31, kh = lane >> 5;
            const bf16* xr = xs + (size_t)(tok0 + j) * DM + 8 * kh + 512 * kq;
            const u32x4* wp = (const u32x4*)(ws + WS_RW3) + ((size_t)(L * NB + b) * 2 + kq) * (32 * 3 * 64) + lane;
            f32x16 acc; float ss = 0.f;
#pragma unroll
            for (int r = 0; r < 16; ++r) acc[r] = 0.f;
#define RT_LD(S_, A_, X_) { A_[0] = wp[((S_) * 3) * 64]; A_[1] = wp[((S_) * 3 + 1) * 64]; A_[2] = wp[((S_) * 3 + 2) * 64]; X_ = *(const u32x4*)(xr + 16 * (S_)); }
#define RT_MM(A_, X_) { const u32x4 xw = X_; \
                const f32x4 b0 = (f32x4){bf2f(xw.x & 0xffffu), bf2f(xw.x >> 16), bf2f(xw.y & 0xffffu), bf2f(xw.y >> 16)}, b1 = (f32x4){bf2f(xw.z & 0xffffu), bf2f(xw.z >> 16), bf2f(xw.w & 0xffffu), bf2f(xw.w >> 16)}; \
                ss += (b0[0] * b0[0] + b0[1] * b0[1]) + (b0[2] * b0[2] + b0[3] * b0[3]) + (b1[0] * b1[0] + b1[1] * b1[1]) + (b1[2] * b1[2] + b1[3] * b1[3]); \
                const bf16x8 xb = __builtin_bit_cast(bf16x8, xw); \
                acc = __builtin_amdgcn_mfma_f32_32x32x16_bf16(__builtin_bit_cast(bf16x8, A_[2]), xb, acc, 0, 0, 0); \
                acc = __builtin_amdgcn_mfma_f32_32x32x16_bf16(__builtin_bit_cast(bf16x8, A_[1]), xb, acc, 0, 0, 0); \
                acc = __builtin_amdgcn_mfma_f32_32x32x16_bf16(__builtin_bit_cast(bf16x8, A_[0]), xb, acc, 0, 0, 0); }
            u32x4 qa[3], ra[3], qx, rx;
            RT_LD(0, qa, qx); RT_LD(1, ra, rx);
#pragma unroll 4
            for (int s = 0; s < 32; s += 2) {
                const int s2 = s + 2 < 32 ? s + 2 : 31, s3 = s + 3 < 32 ? s + 3 : 31;
                { u32x4 ta[3] = {qa[0], qa[1], qa[2]}; const u32x4 tx = qx; RT_LD(s2, qa, qx); __builtin_amdgcn_sched_barrier(0); RT_MM(ta, tx); __builtin_amdgcn_sched_barrier(0); }
                { u32x4 ta[3] = {ra[0], ra[1], ra[2]}; const u32x4 tx = rx; RT_LD(s3, ra, rx); __builtin_amdgcn_sched_barrier(0); RT_MM(ta, tx); __builtin_amdgcn_sched_barrier(0); }
            }
            __syncthreads();
            if (kq == 1) {
#pragma unroll
                for (int r = 0; r < 16; ++r) xch[lane * 17 + r] = acc[r];
                xch[lane * 17 + 16] = ss; }
            __syncthreads();
            float rstd = 0.f;
            if (kq == 0) {
#pragma unroll
                for (int r = 0; r < 16; ++r) acc[r] += xch[lane * 17 + r];
                ss += xch[lane * 17 + 16];
                ss += __shfl_xor(ss, 32);
                rstd = rsqrtf(ss * (1.0f / DM) + EPS);
                if constexpr (MOE1_FP8 != 0) { if (kh == 0) rsx[j] = rstd; } }
            if constexpr (MOE1_FP8 != 0) {
                __syncthreads();
                if (kq == 1) {
                    f32x4 am[4], sm[4];
#pragma unroll
                    for (int jj = 0; jj < 4; ++jj) { const int c4 = lane + 64 * jj; am[jj] = ((const f32x4*)g)[c4] * (((const f32x4*)(ml + 4096 + (size_t)b * 6144))[c4] + 1.0f) * F8_SH; sm[jj] = ((const f32x4*)(ml + 3072 + (size_t)b * 6144))[c4] * F8_SH; }
                    u32x2 va[4][4], vb[4][4];
#define H2_LD(V_, R0_) { _Pragma("unroll") for (int q_ = 0; q_ < 4; ++q_) { _Pragma("unroll") for (int jj = 0; jj < 4; ++jj) V_[q_][jj] = ((const u32x2*)(xs + (size_t)(tok0 + (R0_) + q_) * DM))[lane + 64 * jj]; } }
#define H2_CV(V_, R0_) { _Pragma("unroll") for (int q_ = 0; q_ < 4; ++q_) { const float rs = rsx[(R0_) + q_]; _Pragma("unroll") for (int jj = 0; jj < 4; ++jj) { \
                            const f32x4 v = (f32x4){bf2f(V_[q_][jj].x & 0xffffu), bf2f(V_[q_][jj].x >> 16), bf2f(V_[q_][jj].y & 0xffffu), bf2f(V_[q_][jj].y >> 16)}; \
                            const f32x4 h = v * rs * am[jj] + sm[jj]; ((unsigned*)((unsigned char*)HA + (size_t)(tok0 + (R0_) + q_) * DM))[lane + 64 * jj] = pk4_fp8(h.x, h.y, h.z, h.w); } } }
                    H2_LD(va, 0);
#pragma unroll 1
                    for (int r0 = 0; r0 < 32; r0 += 8) {
                        H2_LD(vb, r0 + 4); __builtin_amdgcn_sched_barrier(0); H2_CV(va, r0); __builtin_amdgcn_sched_barrier(0);
                        const int rn = r0 + 8 < 32 ? r0 + 8 : 24;
                        H2_LD(va, rn); __builtin_amdgcn_sched_barrier(0); H2_CV(vb, r0 + 4); __builtin_amdgcn_sched_barrier(0); }
                    continue; }
            } else { if (kq == 1) continue; }
            const float* cb = (const float*)(ws + WS_RCB) + (size_t)(L * NB + b) * NE;
            float tv[4] = {-INFINITY, -INFINITY, -INFINITY, -INFINITY}; int ti[4] = {64, 65, 66, 67};
#pragma unroll
            for (int r = 0; r < 16; ++r) { const int e = (r & 3) + 8 * (r >> 2) + 4 * kh; top4_insert(acc[r] * rstd + cb[e], e, tv, ti); }
            float pv[4]; int pi[4];
#pragma unroll
            for (int k = 0; k < 4; ++k) { pv[k] = __shfl_xor(tv[k], 32); pi[k] = __shfl_xor(ti[k], 32); }
#pragma unroll
            for (int k = 0; k < 4; ++k) top4_insert(pv[k], pi[k], tv, ti);
            float pe[4], sum = 0.f;
#pragma unroll
            for (int k = 0; k < 4; ++k) { pe[k] = __expf(tv[k] - tv[0]); sum += pe[k]; }
            const float rs = 1.0f / sum;
            const bool own = kh == 0; int mycnt = 0;
            for (int e = 0; e < NE; ++e) { const bool sel = own && (ti[0] == e || ti[1] == e || ti[2] == e || ti[3] == e); const int c = __builtin_popcountll(__ballot(sel)); if (lane == e) mycnt = c; }
            int basev = 0;
            { LAS int* agc = (LAS int*)(F.lds + 17920); LAS int* agb = agc + 128; volatile LAS int* agf = (volatile LAS int*)(agc + 256);
                const int s_ = F.wave, tag = (tile - T) / (F.G * 4) + 1;
                if (lane < NE) agc[s_ * 32 + lane] = mycnt;
                LDS_WAIT(); if (lane == 0) agf[s_] = tag;
                if (s_ == 0) {
                    for (int sp = 0; sp < (1 << 20) && (agf[1] != tag || agf[2] != tag || agf[3] != tag); ++sp) __builtin_amdgcn_s_sleep(1);
                    int c0 = 0, c1 = 0, c2 = 0, c3 = 0; if (lane < NE) { c0 = agc[lane]; c1 = agc[32 + lane]; c2 = agc[64 + lane]; c3 = agc[96 + lane]; }
                    const int tot = c0 + c1 + c2 + c3; int bs_ = 0; if (lane < NE && tot > 0) bs_ = atomicAdd(&cl[lane], tot);
                    if (lane < NE) { agb[lane] = bs_; agb[32 + lane] = bs_ + c0; agb[64 + lane] = bs_ + c0 + c1; agb[96 + lane] = bs_ + c0 + c1 + c2; }
                    LDS_WAIT(); if (lane == 0) agf[4] = tag; }
                for (int sp = 0; sp < (1 << 20) && agf[4] != tag; ++sp) __builtin_amdgcn_s_sleep(1);
                if (lane < NE) basev = agb[s_ * 32 + lane]; }
            const unsigned long long ltmask = (1ull << lane) - 1ull;
            for (int e = 0; e < NE; ++e) { const bool sel = own && (ti[0] == e || ti[1] == e || ti[2] == e || ti[3] == e); const unsigned long long m = __ballot(sel); const int base = __builtin_amdgcn_readlane(basev, e);
                if (sel) { const int k = ti[0] == e ? 0 : ti[1] == e ? 1 : ti[2] == e ? 2 : 3; const float p = (k == 0 ? pe[0] : k == 1 ? pe[1] : k == 2 ? pe[2] : pe[3]) * rs;
                    const int slot = base + __builtin_popcountll(m & ltmask); rowt[e * CAP + slot] = (tok0 + j) * 4 + k; rowp[e * CAP + slot] = p; } }
        }
    }
    if constexpr (MOE1_FP8 == 0) {
    const float* g = args.in[5] + L * DM;
    u32x2 vn[4];
#pragma unroll
    for (int j = 0; j < 4; ++j) vn[j] = ((const u32x2*)(xs + (size_t)gw * DM))[lane + 64 * j];
    for (int row = gw; row < NTOK; row += NGW) {
        const int b = row / SEQ; f32x4 v[4];
#pragma unroll
        for (int j = 0; j < 4; ++j) v[j] = (f32x4){bf2f(vn[j].x & 0xffffu), bf2f(vn[j].x >> 16), bf2f(vn[j].y & 0xffffu), bf2f(vn[j].y >> 16)};
        if (row + NGW < NTOK) {
#pragma unroll
            for (int j = 0; j < 4; ++j) vn[j] = ((const u32x2*)(xs + (size_t)(row + NGW) * DM))[lane + 64 * j]; }
        if constexpr (MOE1_FP8 != 0) {
            float ss = 0.f;
#pragma unroll
            for (int j = 0; j < 4; ++j) ss += v[j].x * v[j].x + v[j].y * v[j].y + v[j].z * v[j].z + v[j].w * v[j].w;
            const float rstd = rsqrtf(wave_sum(ss) * (1.0f / DM) + EPS);
#pragma unroll
            for (int j = 0; j < 4; ++j) { const int c4 = lane + 64 * j; const f32x4 gg = ((const f32x4*)g)[c4], sh = ((const f32x4*)(ml + 3072 + (size_t)b * 6144))[c4], sc = ((const f32x4*)(ml + 4096 + (size_t)b * 6144))[c4];
                const f32x4 h = (v[j] * rstd * gg * (sc + 1.0f) + sh) * F8_SH; ((unsigned*)((unsigned char*)HA + (size_t)row * DM))[c4] = pk4_fp8(h.x, h.y, h.z, h.w); }
        } else {
            ModP p{g, ml + 3072, ml + 4096, HA + (size_t)row * DM};
            norm_mod_regs<1>(v, b, lane, p, 6144, p, 6144);
        }
    }
    }
}
template <int L> __device__ __forceinline__ const LAS int* moe_table(const Frame& F0, const Args& args) {
    const Frame F = phase_frame(F0);
    LAS int* tab = (LAS int*)(F.lds + MISC_OFF + 64);
    const int* cl = (const int*)(args.ws + WS_CTL) + CW_CNT + L * 64;
    __syncthreads();
    if (F.tid < 32) { const int e = F.tid; const int cn = cl[e]; const int tl = (cn + 255) >> 8; int incl = tl;
#pragma unroll
        for (int o = 1; o < 32; o <<= 1) { const int t = __shfl_up(incl, o, 32); if (e >= o) incl += t; }
        tab[e] = incl - tl; tab[33 + e] = cn; if (e == 31) tab[32] = incl; }
    __syncthreads();
    return tab;
}
template <int L> __device__ __forceinline__ void ph_moe1(const Frame& F, const Args& args) {
    unsigned char* ws = args.ws;
    ProbMoe1 P; P.S.tab = moe_table<L>(F, args); P.S.NN = 8; P.S.G = F.G; P.S.c = F.vcu;
    P.H = (const char*)(ws + WS_HA); P.W1 = (const char*)(ws + WS_W1); P.rowt = (const int*)(ws + WS_ROWT); P.bg = args.in[23] + (size_t)L * NE * DM; P.bu = args.in[25] + (size_t)L * NE * DM; P.Abuf = (unsigned char*)(ws + WS_A);
    pg8::gemm_phase<ProbMoe1, true>(F.lds, P, F.wave);
}
template <int L> __device__ __forceinline__ void ph_moe2(const Frame& F, const Args& args) {
    unsigned char* ws = args.ws;
    ProbMoe2 P; P.S.tab = moe_table<L>(F, args); P.S.NN = 4; P.S.G = F.G; P.S.c = F.vcu;
    P.Abuf = (const char*)(ws + WS_A); P.W2 = (const char*)(ws + WS_W2); P.rowt = (const int*)(ws + WS_ROWT); P.rowp = (const float*)(ws + WS_ROWP); P.bd = args.in[27] + (size_t)L * NE * DM; P.Y = (bf16*)(ws + WS_Y); P.trash = (bf16*)(ws + WS_TRASH);
    pg8::gemm_phase<ProbMoe2, true>(F.lds, P, F.wave);
}
template <int L, bool NORM> __device__ __forceinline__ void ph_combine(const Frame& F0, const Args& args) {
    const Frame F = phase_frame(F0);
    unsigned char* ws = args.ws; const float* mod = (const float*)(ws + WS_MOD); const float* ml = mod + (size_t)L * NB * 6144; const float* kvmod = (const float*)(ws + WS_KVMOD);
    const bf16* Y = (const bf16*)(ws + WS_Y); bf16* HA = (bf16*)(ws + WS_HA); bf16* HB = (bf16*)(ws + WS_HB); float* out = args.out; bf16* xs = (bf16*)(ws + WS_XS);
    const int lane = F.lane; const int gw = F.vcu * NWAVES + F.wave, NGW = F.G * NWAVES;
    const int R = NTOK / NGW; int bcur = -1;
    f32x4 gg[4], akv[4], skv[4], aq[4], sq[4];
    int yn[4][4]; u32x2 xn[4];
#define CMB_LOAD(row_) do { _Pragma("unroll") for (int j_ = 0; j_ < 4; ++j_) { const int c4_ = lane + 64 * j_; \
        _Pragma("unroll") for (int k_ = 0; k_ < 4; ++k_) yn[j_][k_] = ((const int*)((const unsigned char*)Y + (size_t)((row_) * 4 + k_) * DM))[c4_]; \
        xn[j_] = ((const u32x2*)(xs + (size_t)(row_) * DM))[c4_]; } } while (0)
    if (R > 0) CMB_LOAD(gw * R);
    for (int i = 0; i <= R; ++i) {
        const int row = i < R ? gw * R + i : NGW * R + gw; if (i == R && row >= NTOK) break;
        const int b = row / SEQ;
        if (i == R) CMB_LOAD(row);
        int yc[4][4]; u32x2 xc[4];
#pragma unroll
        for (int j = 0; j < 4; ++j) { xc[j] = xn[j];
#pragma unroll
            for (int k = 0; k < 4; ++k) yc[j][k] = yn[j][k]; }
        if (i + 1 < R) CMB_LOAD(row + 1);
        if (b != bcur) { bcur = b;
#pragma unroll
            for (int j = 0; j < 4; ++j) { const int c4 = lane + 64 * j; gg[j] = ((const f32x4*)(ml + 5120 + (size_t)b * 6144))[c4] * (Y_FP8 ? 1.0f / F8_SY : 1.0f);
                if (NORM) { const float* m1 = mod + (size_t)NB * 6144;
                    akv[j] = ((const f32x4*)args.in[14])[c4] * (((const f32x4*)(kvmod + 1024 + (size_t)b * 2048))[c4] + 1.0f); skv[j] = ((const f32x4*)(kvmod + (size_t)b * 2048))[c4];
                    aq[j] = ((const f32x4*)(args.in[4] + DM))[c4] * (((const f32x4*)(m1 + 1024 + (size_t)b * 6144))[c4] + 1.0f); sq[j] = ((const f32x4*)(m1 + (size_t)b * 6144))[c4]; } } }
        f32x4 v[4];
#pragma unroll
        for (int j = 0; j < 4; ++j) { const int c4 = lane + 64 * j; f32x4 s = (f32x4){0.f, 0.f, 0.f, 0.f};
#pragma unroll
            for (int k = 0; k < 4; ++k) {
                if constexpr (Y_FP8 != 0) { const int w = yc[j][k]; const f32x2 lo = __builtin_amdgcn_cvt_pk_f32_fp8(w, false), hi = __builtin_amdgcn_cvt_pk_f32_fp8(w, true); s.x += lo.x; s.y += lo.y; s.z += hi.x; s.w += hi.y; }
                else { const u32x2 w = ((const u32x2*)(Y + (size_t)(row * 4 + k) * DM))[c4]; s.x += bf2f(w.x & 0xffffu); s.y += bf2f(w.x >> 16); s.z += bf2f(w.y & 0xffffu); s.w += bf2f(w.y >> 16); } }
            u32x2* xp = (u32x2*)(xs + (size_t)row * DM) + c4; const u32x2 xw = xc[j];
            v[j] = (f32x4){bf2f(xw.x & 0xffffu), bf2f(xw.x >> 16), bf2f(xw.y & 0xffffu), bf2f(xw.y >> 16)} + gg[j] * s;
            if (NORM) { u32x2 o; o.x = cvt_pk_bf16(v[j].x, v[j].y); o.y = cvt_pk_bf16(v[j].z, v[j].w); *xp = o; }
            else ((f32x4*)(out + (size_t)row * DM))[c4] = v[j]; }
        if (NORM) { float ss = 0.f;
#pragma unroll
            for (int j = 0; j < 4; ++j) ss += v[j].x * v[j].x + v[j].y * v[j].y + v[j].z * v[j].z + v[j].w * v[j].w;
            const float rstd = rsqrtf(wave_sum(ss) * (1.0f / DM) + EPS);
#pragma unroll
            for (int j = 0; j < 4; ++j) { const int c4 = lane + 64 * j; const f32x4 xh = v[j] * rstd; const f32x4 hk = xh * akv[j] + skv[j], hq = xh * aq[j] + sq[j];
                u32x2 wk; wk.x = pk2(hk.x, hk.y); wk.y = pk2(hk.z, hk.w); ((u32x2*)(HA + (size_t)row * DM))[c4] = wk;
                u32x2 wq; wq.x = pk2(hq.x, hq.y); wq.y = pk2(hq.z, hq.w); ((u32x2*)(HB + (size_t)row * DM))[c4] = wq; } }
    }
#undef CMB_LOAD
}

__global__ void __launch_bounds__(NTHREADS, 2) mega(Args args) {
    extern __shared__ __attribute__((aligned(16))) unsigned char lds_raw[];
    Frame FK; Frame& F = FK; F.lds = (LAS unsigned char*)lds_raw; F.wave = __builtin_amdgcn_readfirstlane((int)threadIdx.x >> 6); F.tid = my_tid(F.wave); F.lane = F.tid & 63;
    F.G = gridDim.x; { const int bx = blockIdx.x; F.vcu = (F.G % 8 == 0) ? (bx % 8) * (F.G / 8) + bx / 8 : bx; }
    volatile LAS unsigned* MISC = (volatile LAS unsigned*)(F.lds + MISC_OFF);
    unsigned char* ws = args.ws;
    for (int u = F.tid; u < (LDS_BYTES - MISC_OFF) / 4; u += NTHREADS) MISC[u] = 0u;
    __syncthreads();
    XcdBarrier bar = xcd_barrier_post((unsigned*)(ws + WS_CTL) + CW_BAR, MISC + 8, my_tid(F.wave) == 0);
    const int lo = args.ph_lo, hi = args.ph_hi;
#define IN(k) (lo <= (k) && (k) < hi)
#define SEAM(k) do { if (IN(k) && IN((k) + 1)) xcd_barrier(bar, my_tid(FK.wave) == 0); } while (0)

    if (CK(0) && IN(0)) DUP(0) {
        __syncthreads();
        const Frame F = phase_frame(FK);
        const int gw = F.vcu * NWAVES + F.wave, NGW = F.G * NWAVES;
        float* mod = (float*)(ws + WS_MOD); float* kvmod = (float*)(ws + WS_KVMOD);
        LAS float* cact = (LAS float*)F.lds;
        for (int i = F.tid; i < NB * DM; i += NTHREADS) { const float v = args.in[1][i]; cact[i] = v / (1.0f + __expf(-v)); }
        __syncthreads();
        for (int r = NGW - 1 - gw; r < 896; r += NGW) {
            const int j = r * 16 + (F.lane & 15), kq = F.lane >> 4; const float* W; int ld, col; float bias; float* o; int ostride;
            if (j < 2 * 6144) { const int l = j / 6144; col = j % 6144; W = args.in[2] + (size_t)l * DM * 6144; ld = 6144; bias = args.in[3][l * 6144 + col]; o = mod + (size_t)l * NB * 6144 + col; ostride = 6144; }
            else { col = j - 2 * 6144; W = args.in[12]; ld = 2048; bias = args.in[13][col]; o = kvmod + col; ostride = 2048; }
            float a8[NB];
#pragma unroll
            for (int b = 0; b < NB; ++b) a8[b] = 0.f;
#pragma unroll 16
            for (int k = kq * 256; k < kq * 256 + 256; ++k) { const float w = W[(size_t)k * ld + col];
#pragma unroll
                for (int b = 0; b < NB; ++b) a8[b] += cact[b * DM + k] * w; }
#pragma unroll
            for (int b = 0; b < NB; ++b) { a8[b] += __shfl_xor(a8[b], 16); a8[b] += __shfl_xor(a8[b], 32); }
            if (kq == 0) {
#pragma unroll
                for (int b = 0; b < NB; ++b) o[(size_t)b * ostride] = a8[b] + bias; }
        }
        for (int i = gw * 64 + F.lane; i < NB * NH * 16 * HD / 4; i += NGW * 64) ((f32x4*)(ws + WS_KMEAN))[i] = (f32x4){0.f, 0.f, 0.f, 0.f};
        LAS float* scr = (LAS float*)(F.lds + 32768 + F.wave * 8448);
        constexpr int I_IN = 16 * 192, I_OUT = 48 * 32, I_KV = 16 * 64, I_Q = 16 * 32, I_O = 16 * 32;
        constexpr int NIT = I_IN + I_OUT + I_KV + I_Q + I_O;
        auto decode = [&](int it) -> CvtItem { int r = it;
            if (r < I_IN) return cvt_plain(args.in[6], DM, 6144, ws + WS_WIN, r, SGU1_FP8 != 0); r -= I_IN;
            if (r < I_OUT) return cvt_plain(args.in[11], DS, DM, ws + WS_WOUT, r, false); r -= I_OUT;
            if (r < I_KV) return cvt_plain(args.in[15], DM, 2048, ws + WS_WKV, r, false); r -= I_KV;
            if (r < I_Q) return cvt_plain(args.in[17], DM, DM, ws + WS_WQ, r, false); r -= I_Q;
            return cvt_plain(args.in[19], DM, DM, ws + WS_WO, r, false); };
        if (gw < NIT) { CvtItem cur = decode(gw); f32x4 va[8], vb[8]; cvt_load(cur, va, F.lane);
            for (int it = gw; it < NIT; it += 2 * NGW) {
                const bool h1 = it + NGW < NIT; CvtItem n1 = cur; if (h1) { n1 = decode(it + NGW); cvt_load(n1, vb, F.lane); }
                cvt_store(cur, va, scr, F.lane);
                if (!h1) break;
                const bool h2 = it + 2 * NGW < NIT; if (h2) { cur = decode(it + 2 * NGW); cvt_load(cur, va, F.lane); }
                cvt_store(n1, vb, scr, F.lane);
                if (!h2) break; } }
    }
    SEAM(0);
    if (CK(1) && IN(1)) DUP(1) {
        const Frame F = phase_frame(FK);
        const int gw = F.vcu * NWAVES + F.wave, NGW = F.G * NWAVES; const float* mod = (const float*)(ws + WS_MOD); bf16* HA = (bf16*)(ws + WS_HA); const float* x = args.in[0];
        for (int it = gw; it < 2 * NB * NE; it += NGW) {
            const int e = it & 31, b = (it >> 5) & 7, l = it >> 8; const float* m_ = mod + (size_t)(l * NB + b) * 6144; const float* w = args.in[20] + (size_t)l * DM * NE; const float* g2 = args.in[5] + l * DM;
            u32x4* wt3 = (u32x4*)(ws + WS_RW3) + (size_t)(l * NB + b) * (2 * 32 * 3 * 64); float c = 0.f;
#pragma unroll
            for (int i2 = 0; i2 < 2; ++i2) { const int ch = F.lane + 64 * i2, k0 = 8 * ch;
                float wv[8];
#pragma unroll
                for (int p = 0; p < 8; ++p) wv[p] = w[(k0 + p) * NE + e];
                const f32x4 ga = *(const f32x4*)(g2 + k0), gb = *(const f32x4*)(g2 + k0 + 4), sa = *(const f32x4*)(m_ + 4096 + k0), sb = *(const f32x4*)(m_ + 4096 + k0 + 4), ha = *(const f32x4*)(m_ + 3072 + k0), hb = *(const f32x4*)(m_ + 3072 + k0 + 4);
                unsigned hi[8], mi[8], lo[8];
#pragma unroll
                for (int p = 0; p < 8; ++p) { const float gv = p < 4 ? ga[p & 3] : gb[p & 3], sv = p < 4 ? sa[p & 3] : sb[p & 3], hv = p < 4 ? ha[p & 3] : hb[p & 3];
                    const float a_ = gv * (1.0f + sv) * wv[p]; c += hv * wv[p];
                    hi[p] = __builtin_bit_cast(unsigned, a_) & 0xffff0000u; const float r1 = a_ - __builtin_bit_cast(float, hi[p]);
                    mi[p] = __builtin_bit_cast(unsigned, r1) & 0xffff0000u; lo[p] = __builtin_bit_cast(unsigned, r1 - __builtin_bit_cast(float, mi[p])); }
                const int kq_ = i2, s_ = (ch >> 1) & 31, kh_ = ch & 1; u32x4* dst = wt3 + (size_t)((kq_ * 32 + s_) * 3) * 64 + e + 32 * kh_;
                dst[0]   = (u32x4){(hi[0] >> 16) | hi[1], (hi[2] >> 16) | hi[3], (hi[4] >> 16) | hi[5], (hi[6] >> 16) | hi[7]};
                dst[64]  = (u32x4){(mi[0] >> 16) | mi[1], (mi[2] >> 16) | mi[3], (mi[4] >> 16) | mi[5], (mi[6] >> 16) | mi[7]};
                dst[128] = (u32x4){(lo[0] >> 16) | (lo[1] & 0xffff0000u), (lo[2] >> 16) | (lo[3] & 0xffff0000u), (lo[4] >> 16) | (lo[5] & 0xffff0000u), (lo[6] >> 16) | (lo[7] & 0xffff0000u)}; }
            c = wave_sum(c); if (F.lane == 0) ((float*)(ws + WS_RCB))[it] = c + args.in[21][l * NE + e];
        }
        { const int R = NTOK / NGW; int bcur = -1; f32x4 am[4], sm[4], vn[4];
            const int row0 = gw * R;
#pragma unroll
            for (int j = 0; j < 4; ++j) vn[j] = ((const f32x4*)(x + (size_t)(R > 0 ? row0 : gw) * DM))[F.lane + 64 * j];
            for (int i = 0; i <= R; ++i) {
                const int row = i < R ? row0 + i : NGW * R + gw; if (i == R && row >= NTOK) break;
                const int b = row / SEQ; f32x4 v[4];
                if (i == R && R > 0) {
#pragma unroll
                    for (int j = 0; j < 4; ++j) vn[j] = ((const f32x4*)(x + (size_t)row * DM))[F.lane + 64 * j]; }
#pragma unroll
                for (int j = 0; j < 4; ++j) v[j] = vn[j];
                if (i + 1 < R) {
#pragma unroll
                    for (int j = 0; j < 4; ++j) vn[j] = ((const f32x4*)(x + (size_t)(row + 1) * DM))[F.lane + 64 * j]; }
                if (b != bcur) { bcur = b;
#pragma unroll
                    for (int j = 0; j < 4; ++j) { const int c4 = F.lane + 64 * j; am[j] = ((const f32x4*)args.in[4])[c4] * (((const f32x4*)(mod + 1024 + (size_t)b * 6144))[c4] + 1.0f); sm[j] = ((const f32x4*)(mod + (size_t)b * 6144))[c4]; } }
                float ss = 0.f;
#pragma unroll
                for (int j = 0; j < 4; ++j) ss += v[j].x * v[j].x + v[j].y * v[j].y + v[j].z * v[j].z + v[j].w * v[j].w;
                const float rstd = rsqrtf(wave_sum(ss) * (1.0f / DM) + EPS);
#pragma unroll
                for (int j = 0; j < 4; ++j) { const int c4 = F.lane + 64 * j; const f32x4 h = v[j] * rstd * am[j] + sm[j];
                    if constexpr (SGU1_FP8 != 0) { const f32x4 h8 = h * F8_SH; ((unsigned*)((unsigned char*)HA + (size_t)row * DM))[c4] = pk4_fp8(h8.x, h8.y, h8.z, h8.w); }
                    else { u32x2 w; w.x = pk2(h.x, h.y); w.y = pk2(h.z, h.w); ((u32x2*)(HA + (size_t)row * DM))[c4] = w; } } } }
    }
    SEAM(1);
    if (CK(2) && IN(2)) {
        ProbSguIn P; P.A = (const char*)(ws + WS_HA); P.Bt = (const char*)(ws + WS_WIN); P.S.init(NTOK, 6144, F.G, (int)blockIdx.x); P.bias = args.in[7]; P.U = (bf16*)(ws + WS_U); P.V = (bf16*)(ws + WS_V); P.vpart = (float*)(ws + WS_VPART);
        P.side.wg = args.in[22]; P.side.wu = args.in[24]; P.side.wd = args.in[26]; P.side.W1 = ws + WS_W1; P.side.W2 = ws + WS_W2; P.side.trash = ws + WS_TRASH; P.side.c = F.vcu; P.side.G = F.G;
        if constexpr (ProbSguIn::SIDE) { DUP(2) pg8::gemm_phase<ProbSguIn, true>(F.lds, P, F.wave); }
        else { DUP(2) { const int kc = F.vcu % 12;
            P.S.i0 = 0; P.S.i1 = kc; pg8::gemm_phase<ProbSguIn, true>(F.lds, P, F.wave);
            __syncthreads(); cvt_moe_share(FK, args, 0); __syncthreads();
            P.S.i0 = kc; P.S.i1 = 1 << 30; pg8::gemm_phase<ProbSguIn, true>(F.lds, P, F.wave); } }
    }
    SEAM(2);
    if (CK(3) && IN(3)) {
        const Frame F = phase_frame(FK);
        constexpr int VS = 800, AS = 272, OFF_A = 128 * VS, OFF_RS = OFF_A + 128 * AS, OFF_VG = OFF_RS + 512;
        bf16* U = (bf16*)(ws + WS_U); const bf16* V = (const bf16*)(ws + WS_V); const float* vpart = (const float*)(ws + WS_VPART);
        const float* w_s = args.in[9]; const float* b_s = args.in[10]; const float* v_g = args.in[8];
        LAS unsigned char* Vs = F.lds; LAS unsigned char* As = F.lds + OFF_A; LAS float* rs = (LAS float*)(F.lds + OFF_RS);
        const int lane = F.lane, w = F.wave, gq = lane >> 4, li = lane & 15;
        for (int chunk = F.vcu; chunk < NTOK / 128; chunk += F.G) {
            const int tok0 = chunk * 128;
            __syncthreads();
            if (F.tid < 128) { const float* pp = vpart + (size_t)(tok0 + F.tid) * 48; float ss = 0.f;
#pragma unroll
                for (int q = 0; q < 12; ++q) { const f32x4 a = ((const f32x4*)pp)[q]; ss += (a.x + a.y) + (a.z + a.w); }
                rs[F.tid] = rsqrtf(ss * (1.0f / DS) + EPS); }
            u32x4 vreg[12], ureg[12];
            const unsigned goff = (unsigned)((F.tid >> 4) * DS + (F.tid & 15) * 8) * 2u, loff = (unsigned)((F.tid >> 4) * VS + (F.tid & 15) * 16);
            const char* Vc = (const char*)(V + (size_t)tok0 * DS); char* Uc = (char*)(U + (size_t)tok0 * DS);
#define MIX_G(rb, cb) ((size_t)(rb) * 32 * DS * 2 + (cb) * 256)
#define MIX_L(rb, cb) ((rb) * 32 * VS + (cb) * 256)
#pragma unroll
            for (int i = 0; i < 12; ++i) vreg[i] = *(const u32x4*)(Vc + MIX_G(i / 3, i % 3) + goff);
#pragma unroll 1
            for (int g = 0; g < 8; ++g) {
                const int ch0 = g * 384;
                __syncthreads();
                int tq_ = F.tid; asm volatile("" : "+v"(tq_));
#pragma unroll
                for (int i = 0; i < 12; ++i) *(LAS u32x4*)(Vs + MIX_L(i / 3, i % 3) + loff) = vreg[i];
                const float bsv = b_s[g * 128 + ((tq_ >> 6) * 16 + (tq_ & 15))];
                { const int slot = (tq_ & 63) * 2, ks_ = slot >> 5, q4 = (slot >> 3) & 3, j_ = slot & 7, t0 = tq_ >> 6;
                    const int sx = 32 * ks_ + 16 * (q4 >> 1) + 8 * (j_ >> 2) + 4 * (q4 & 1) + (j_ & 3); const float r0 = rs[sx], r1 = rs[sx + 1];
                    const float* wp = w_s + ((size_t)g * 128 + t0) * 128 + sx; LAS unsigned char* ap = As + t0 * AS + slot * 2;
                    const f32x4 vgl = ((const f32x4*)(v_g + ch0))[tq_ < 96 ? tq_ : 0];
                    f32x2 wv[16];
#pragma unroll
                    for (int i = 0; i < 16; ++i) wv[i] = *(const f32x2*)(wp + i * 1024);
                    __builtin_amdgcn_sched_barrier(0);
#pragma unroll
                    for (int i = 0; i < 16; ++i) { const int t = t0 + 8 * i;
                        const float a = (sx <= t) ? wv[i].x * r0 : 0.f, b = (sx + 1 <= t) ? wv[i].y * r1 : 0.f;
                        *(LAS unsigned*)(ap + i * 8 * AS) = pk2(a, b); }
                    if (tq_ < 96) ((LAS f32x4*)(F.lds + OFF_VG))[tq_] = vgl; }
                __builtin_amdgcn_sched_barrier(0);
#pragma unroll
                for (int i = 0; i < 12; ++i) ureg[i] = *(const u32x4*)(Uc + (size_t)ch0 * 2 + MIX_G(i / 3, i % 3) + goff);
                if (g < 7) {
#pragma unroll
                    for (int i = 0; i < 12; ++i) vreg[i] = *(const u32x4*)(Vc + (size_t)(ch0 + 384) * 2 + MIX_G(i / 3, i % 3) + goff); }
                __syncthreads();
                f32x4 acc[24];
#pragma unroll
                for (int n = 0; n < 24; ++n) acc[n] = (f32x4){0.f, 0.f, 0.f, 0.f};
                const int kmax = w >> 1;
#pragma unroll 1
                for (int ks = 0; ks <= kmax; ++ks) {
                    const bf16x8 af = *(const LAS bf16x8*)(As + (16 * w + li) * AS + (32 * ks + 8 * gq) * 2);
                    const LAS unsigned char* vb = Vs + (32 * ks + 16 * (gq >> 1) + 4 * (gq & 1) + (li >> 2)) * VS + (li & 3) * 8;
#pragma unroll
                    for (int n = 0; n < 24; ++n) {
                        const attn_body::s16x4 lo = attn_body::vtr((attn_body::lds_cptr)(vb + n * 32)), hi = attn_body::vtr((attn_body::lds_cptr)(vb + n * 32 + 8 * VS));
                        const bf16x8 vf = (bf16x8){lo[0], lo[1], lo[2], lo[3], hi[0], hi[1], hi[2], hi[3]};
                        acc[n] = __builtin_amdgcn_mfma_f32_16x16x32_bf16(vf, af, acc[n], 0, 0, 0); if ((n & 3) == 3) __builtin_amdgcn_sched_barrier(0); }
                }
                __syncthreads();
                { const int t = 16 * w + li; const float bs = bsv; LAS const unsigned char* vgb = F.lds + OFF_VG + 16 * ((tq_ >> 4) & 3); asm volatile("" : "+v"(vgb));
#pragma unroll
                    for (int n = 0; n < 24; ++n) { const f32x4 vg = *(const LAS f32x4*)(vgb + n * 64); const f32x4 gt = vg * acc[n] + bs;
                        u32x2 o; o.x = pk2(gt[0], gt[1]); o.y = pk2(gt[2], gt[3]); *(LAS u32x2*)(Vs + t * VS + (16 * n + 4 * gq) * 2) = o; if ((n & 1) == 1) __builtin_amdgcn_sched_barrier(0); } }
                __syncthreads();
#pragma unroll
                for (int i = 0; i < 12; ++i) {
                    const u32x4 gv = *(const LAS u32x4*)(Vs + MIX_L(i / 3, i % 3) + loff); const u32x4 uv = ureg[i]; u32x4 o;
#pragma unroll
                    for (int q = 0; q < 4; ++q) o[q] = pk2(bf2f(uv[q] & 0xffffu) * bf2f(gv[q] & 0xffffu), bf2f(uv[q] >> 16) * bf2f(gv[q] >> 16));
                    *(u32x4*)(Uc + (size_t)ch0 * 2 + MIX_G(i / 3, i % 3) + goff) = o; }
            }
        }
    }
#undef MIX_G
#undef MIX_L
    SEAM(3);
    if (CK(4) && IN(4)) {
        ProbResid<3072, false> P; P.A = (const char*)(ws + WS_U); P.Bt = (const char*)(ws + WS_WOUT); P.S.init(NTOK, DM, F.G, (int)blockIdx.x); P.xin = args.in[0]; P.xout = (bf16*)(ws + WS_XS); P.gate = (const float*)(ws + WS_MOD) + 2048;
        DUP(4) pg8::gemm_phase<ProbResid<3072, false>, true>(F.lds, P, F.wave);
    }
    SEAM(4);
    if (CK(5) && IN(5)) ph_router<0>(F, args);
    SEAM(5);
    if (CK(6) && IN(6)) DUP(6) ph_moe1<0>(F, args);
    SEAM(6);
    if (CK(7) && IN(7)) DUP(7) ph_moe2<0>(F, args);
    SEAM(7);
    if (CK(8) && IN(8)) {
        ph_combine<0, true>(FK, args);
    }
    SEAM(8);
    if (CK(9) && IN(9)) {
        ProbHead P; P.A = (const char*)(ws + WS_HA); P.Bt = (const char*)(ws + WS_WKV); P.A2 = (const char*)(ws + WS_HB); P.Bt2 = (const char*)(ws + WS_WQ); P.S.init(NTOK, 3072, F.G, (int)blockIdx.x);
        P.kg = args.in[16]; P.qg = args.in[18]; P.Kb = (bf16*)(ws + WS_K); P.Vb = (bf16*)(ws + WS_VV); P.Qb = (bf16*)(ws + WS_Q); P.kmean = (float*)(ws + WS_KMEAN);
        DUP(9) pg8::gemm_phase<ProbHead, true>(F.lds, P, F.wave);
    }
    SEAM(9);
    if (CK(10) && IN(10)) {
        const attn_body::AttnTensors AT{(const attn_body::bf16*)(ws + WS_Q), (const attn_body::bf16*)(ws + WS_K), (const attn_body::bf16*)(ws + WS_VV), (attn_body::bf16*)(ws + WS_O)};
        const attn_body::StaticOrder S((int)F.G, (int)blockIdx.x);
        DUP(10) { attn_body::AttnUnit u, un; const int kc = F.vcu & 7;
            const float* KM = (const float*)(ws + WS_KMEAN); attn_body::bf16x8 qr[4]; attn_body::f32x2_t kmv;
            if (S.next(0, u)) { if (kc != 0) attn_body::attn_preload(u.bh / attn_body::NHEAD, u.bh % attn_body::NHEAD, u.qb, AT.Q, KM + (size_t)u.bh * 16 * 64, qr, kmv, F.wave);
                for (int i = 0;; ++i) {
                    if (i == kc) { __syncthreads(); cvt_moe_share(FK, args, 1); __syncthreads();
                        attn_body::attn_preload(u.bh / attn_body::NHEAD, u.bh % attn_body::NHEAD, u.qb, AT.Q, KM + (size_t)u.bh * 16 * 64, qr, kmv, F.wave); }
                    const bool hn = S.next(i + 1, un); if (!hn) un = u;
                    attn_body::attn_unit(u.bh / attn_body::NHEAD, u.bh % attn_body::NHEAD, u.qb, AT.Q, AT.K, AT.V, AT.O, (char*)lds_raw, F.wave, qr, kmv, un.bh / attn_body::NHEAD, un.bh % attn_body::NHEAD, un.qb, KM + (size_t)un.bh * 16 * 64);
                    if (!hn) break; u = un; } } }
    }
    SEAM(10);
    if (CK(11) && IN(11)) {
        ProbResid<1024, true> P; P.A = (const char*)(ws + WS_O); P.Bt = (const char*)(ws + WS_WO); P.S.init(NTOK, DM, F.G, (int)blockIdx.x); P.xin = ws + WS_XS; P.xout = (bf16*)(ws + WS_XS); P.gate = (const float*)(ws + WS_MOD) + (size_t)NB * 6144 + 2048;
        pg8::gemm_phase<ProbResid<1024, true>, true>(F.lds, P, F.wave);
    }
    SEAM(11);
    if (CK(5) && IN(12)) ph_router<1>(F, args);
    SEAM(12);
    if (CK(6) && IN(13)) ph_moe1<1>(F, args);
    SEAM(13);
    if (CK(7) && IN(14)) ph_moe2<1>(F, args);
    SEAM(14);
    if (CK(15) && IN(15)) ph_combine<1, false>(F, args);
#undef IN
#undef SEAM
}

extern "C" void kernel_launch(void* const* d_in, const int* in_sizes, int n_in, void* d_out, int out_size, void* d_ws, size_t ws_size, hipStream_t stream) {
    static int grid = 0;
    if (grid == 0) {
        if (n_in != 28 || ws_size < WS_END || out_size != NTOK * DM) { fprintf(stderr, "kernel_launch: unexpected sizes n_in=%d ws=%zu out=%d\n", n_in, ws_size, out_size); grid = -1; return; }
        int dev = 0, cus = 0, per_cu = 0;
        if (hipGetDevice(&dev) != hipSuccess || hipDeviceGetAttribute(&cus, hipDeviceAttributeMultiprocessorCount, dev) != hipSuccess) { grid = -1; return; }
        if (hipFuncSetAttribute((const void*)mega, hipFuncAttributeMaxDynamicSharedMemorySize, LDS_BYTES) != hipSuccess) { fprintf(stderr, "kernel_launch: hipFuncSetAttribute failed\n"); grid = -1; return; }
        if (hipOccupancyMaxActiveBlocksPerMultiprocessor(&per_cu, (const void*)mega, NTHREADS, LDS_BYTES) != hipSuccess || per_cu < 1) { fprintf(stderr, "kernel_launch: occupancy query says %d\n", per_cu); }
        (void)hipGetLastError();
        grid = cus;
    }
    if (grid < 0) return;
    (void)hipMemsetAsync((char*)d_ws + WS_CTL, 0, CTL_ZERO_BYTES, stream);
    Args a{};
    for (int i = 0; i < 28; ++i) a.in[i] = (const float*)d_in[i];
    a.out = (float*)d_out; a.ws = (unsigned char*)d_ws; a.ph_lo = 0; a.ph_hi = 16;
    hipLaunchKernelGGL(mega, dim3(grid), dim3(NTHREADS), LDS_BYTES, stream, a);
}
```

```cpp
#include <hip/hip_runtime.h>
#include <stdint.h>
#include <stdio.h>

#define LAS __attribute__((address_space(3)))
#define GAS __attribute__((address_space(1)))
typedef unsigned short bf16;
typedef short bf16x8 __attribute__((ext_vector_type(8)));
typedef float f32x4 __attribute__((ext_vector_type(4)));
typedef float f32x2 __attribute__((ext_vector_type(2)));
typedef unsigned u32x4 __attribute__((ext_vector_type(4)));
typedef unsigned u32x2 __attribute__((ext_vector_type(2)));
typedef int i32x8 __attribute__((ext_vector_type(8)));
typedef int i32x4 __attribute__((ext_vector_type(4)));
#ifndef MOE1_FP8
#define MOE1_FP8 1
#endif
#ifndef SGU1_FP8
#define SGU1_FP8 1
#endif
#ifndef Y_FP8
#define Y_FP8 1
#endif
#ifndef MOE2_FP8
#define MOE2_FP8 1
#endif

constexpr int NTOK = 32768, DM = 1024, NB = 8, SEQ = 4096, DS = 3072, NE = 32, NH = 16, HD = 64;
constexpr int CAP = 32768;
constexpr float EPS = 1e-6f;
constexpr int NWAVES = 8, NTHREADS = 512;
constexpr float QSCALE = 0.125f * 1.4426950408889634f;

constexpr size_t MiB = 1u << 20;
constexpr size_t WS_CTL = 0, CTL_ZERO_BYTES = 32768;
constexpr size_t WS_KMEAN = 1 * MiB;
constexpr size_t WS_MOD = 2 * MiB;
constexpr size_t WS_KVMOD = WS_MOD + 512 * 1024;
constexpr size_t WS_VPART = 3 * MiB;
constexpr size_t WS_ROWT = 10 * MiB;
constexpr size_t WS_ROWP = 14 * MiB;
constexpr size_t WS_WIN = 18 * MiB, WS_WOUT = 30 * MiB, WS_WKV = 36 * MiB, WS_WQ = 40 * MiB, WS_WO = 42 * MiB;
constexpr size_t WS_W1 = 44 * MiB, WS_W2 = 172 * MiB;
constexpr size_t WS_RWT = 236 * MiB;
constexpr size_t WS_RCB = 238 * MiB;
constexpr size_t WS_HA = 240 * MiB, WS_HB = 304 * MiB;
constexpr size_t WS_X = 368 * MiB;
constexpr size_t WS_U = WS_X, WS_V = WS_X + 192 * MiB;
constexpr size_t WS_A = WS_X, WS_Y = WS_X + 272 * MiB;
constexpr size_t WS_Q = WS_X, WS_K = WS_X + 64 * MiB, WS_VV = WS_X + 128 * MiB, WS_O = WS_X + 192 * MiB;
constexpr size_t WS_TRASH = WS_X + 528 * MiB;
constexpr size_t WS_XS = WS_TRASH + 2 * MiB;
constexpr size_t WS_RW3 = WS_XS + 64 * MiB;
constexpr size_t WS_END = WS_RW3 + 4 * MiB;
constexpr int CW_CNT = 64;
constexpr int CW_BAR = 4096;
constexpr int RING_BYTES = 147456;
constexpr int MISC_OFF = RING_BYTES;
constexpr int LDS_BYTES = RING_BYTES + 512;

__device__ __forceinline__ unsigned f2bf(float f) { unsigned u = __builtin_bit_cast(unsigned, f); return (u + 0x7fffu + ((u >> 16) & 1u)) >> 16; }
__device__ __forceinline__ float bf2f(unsigned b) { return __builtin_bit_cast(float, b << 16); }
__device__ __forceinline__ unsigned cvt_pk_bf16(float lo, float hi) { unsigned r; asm volatile("v_cvt_pk_bf16_f32 %0, %1, %2" : "=v"(r) : "v"(lo), "v"(hi)); return r; }
__device__ __forceinline__ unsigned pk2(float lo, float hi) { return cvt_pk_bf16(lo, hi); }
__device__ __forceinline__ unsigned pk4_fp8(float a, float b, float c, float d) {
    a = __builtin_amdgcn_fmed3f(a, -448.f, 448.f); b = __builtin_amdgcn_fmed3f(b, -448.f, 448.f); c = __builtin_amdgcn_fmed3f(c, -448.f, 448.f); d = __builtin_amdgcn_fmed3f(d, -448.f, 448.f);
    int w = 0; w = __builtin_amdgcn_cvt_pk_fp8_f32(a, b, w, false); w = __builtin_amdgcn_cvt_pk_fp8_f32(c, d, w, true); return (unsigned)w; }
__device__ __forceinline__ unsigned pk4_fp8_nc(float a, float b, float c, float d) { int w = 0; w = __builtin_amdgcn_cvt_pk_fp8_f32(a, b, w, false); w = __builtin_amdgcn_cvt_pk_fp8_f32(c, d, w, true); return (unsigned)w; }
constexpr float F8_SW = 64.f, F8_SH = 8.f, F8_SA = 4.f, F8_SY = 16.f;
__device__ __forceinline__ float wave_sum(float v) {
#pragma unroll
    for (int o = 32; o >= 1; o >>= 1) v += __shfl_xor(v, o);
    return v;
}
__device__ __forceinline__ float wave_max(float v) {
#pragma unroll
    for (int o = 32; o >= 1; o >>= 1) v = fmaxf(v, __shfl_xor(v, o));
    return v;
}
__device__ __forceinline__ float fast_rcp(float x) { return __builtin_amdgcn_rcpf(x); }
__device__ __forceinline__ f32x2 gelu_tanh2(f32x2 x) {
    constexpr float KK = -2.0f * 0.7978845608028654f * 1.4426950408889634f;
    const f32x2 t = (x * x) * (0.044715f * KK) + KK; const f32x2 a = x * t;
    f32x2 e; e.x = __builtin_amdgcn_exp2f(a.x); e.y = __builtin_amdgcn_exp2f(a.y);
    const f32x2 d = e + 1.0f; f32x2 r; r.x = fast_rcp(d.x); r.y = fast_rcp(d.y);
    return x * r;
}

__device__ __forceinline__ int lane_id() { int l = (int)__builtin_amdgcn_mbcnt_hi(~0u, __builtin_amdgcn_mbcnt_lo(~0u, 0u)); asm volatile("" : "+v"(l)); return l; }
__device__ __forceinline__ int my_tid(int wave) { return wave * 64 + lane_id(); }

#define XB_TMO      128
#define XB_XCNT(j)  (256  + 64 * (j))
#define XB_XSUB(j)  (1280 + 64 * (j))
#define XB_XGEN(j)  (2304 + 64 * (j))
#define XB_TOP      3328
#define XB_TOPGEN   3392
#define XCD_BAR_WORDS 3456
#define XB_SPIN_CAP (1u << 18)
__device__ __forceinline__ unsigned xb_ld(unsigned* p)              { return __hip_atomic_load(p, __ATOMIC_RELAXED, __HIP_MEMORY_SCOPE_AGENT); }
__device__ __forceinline__ unsigned xb_add(unsigned* p, unsigned v) { return __hip_atomic_fetch_add(p, v, __ATOMIC_RELAXED, __HIP_MEMORY_SCOPE_AGENT); }
__device__ __forceinline__ unsigned xb_xcc_id() { return (unsigned)__builtin_amdgcn_s_getreg((3 << 11) | 20) & 0xFu; }
#define XB_SPIN(cond, bar) do { unsigned _sp = 0; while (cond) { __builtin_amdgcn_s_sleep(1); \
    if ((++_sp & 255u) == 0u) { if (xb_ld(&(bar)[XB_TMO])) break; if (_sp > XB_SPIN_CAP) { atomicAdd(&(bar)[XB_TMO], 1u); break; } } } } while (0)
struct XcdBarrier { unsigned* bar; unsigned x; volatile LAS unsigned* st; };
__device__ __forceinline__ XcdBarrier xcd_barrier_post(unsigned* bar, volatile LAS unsigned* st, bool t0) {
    XcdBarrier b; b.bar = bar; b.x = xb_xcc_id(); b.st = st;
    if (t0) (void)xb_add(&bar[XB_XCNT(b.x)], 1u);
    return b;
}
__device__ __forceinline__ void xcd_barrier_complete(unsigned* bar, unsigned x, unsigned& nloc, unsigned& nx) {
    const unsigned G = gridDim.x * gridDim.y * gridDim.z;
    unsigned sum, cnt, mine, sp = 0u;
    for (;;) {
        sum = 0u; cnt = 0u; mine = 0u;
#pragma unroll
        for (unsigned j = 0; j < 16; ++j) { const unsigned c = xb_ld(&bar[XB_XCNT(j)]); sum += c; cnt += (c > 0u) ? 1u : 0u; mine = (j == x) ? c : mine; }
        if (sum == G) break;
        __builtin_amdgcn_s_sleep(1);
        if ((++sp & 255u) == 0u) { if (xb_ld(&bar[XB_TMO])) break; if (sp > XB_SPIN_CAP) { atomicAdd(&bar[XB_TMO], 1u); break; } }
    }
    nloc = mine > 0u ? mine : 1u; nx = cnt > 0u ? cnt : 1u;
}
__device__ __forceinline__ void xcd_barrier(const XcdBarrier& b, bool t0) {
    asm volatile("s_waitcnt vmcnt(0)" ::: "memory");
    __syncthreads();
    if (t0) {
        unsigned* bar = b.bar;
        __builtin_amdgcn_s_waitcnt(0);
        unsigned nloc = b.st[0], nx = b.st[1];
        if (nloc == 0u) { xcd_barrier_complete(bar, b.x, nloc, nx); b.st[0] = nloc; b.st[1] = nx; }
        const unsigned old = xb_add(&bar[XB_XSUB(b.x)], 1u);
        const unsigned gen = old / nloc;
        if (old + 1u == (gen + 1u) * nloc) {
            __builtin_amdgcn_fence(__ATOMIC_RELEASE, "agent");
            asm volatile("s_waitcnt vmcnt(0)" ::: "memory");
            const unsigned og = xb_add(&bar[XB_TOP], 1u);
            const unsigned tg = og / nx;
            if (og + 1u == (tg + 1u) * nx) xb_add(&bar[XB_TOPGEN], 1u);
            else XB_SPIN(xb_ld(&bar[XB_TOPGEN]) == tg, bar);
            __builtin_amdgcn_fence(__ATOMIC_ACQUIRE, "agent");
            asm volatile("s_waitcnt vmcnt(0)" ::: "memory");
        } else {
            XB_SPIN(xb_ld(&bar[XB_TOPGEN]) == gen, bar);
            __builtin_amdgcn_fence(__ATOMIC_ACQUIRE, "agent");
            asm volatile("s_waitcnt vmcnt(0)" ::: "memory");
        }
    }
    __syncthreads();
}

namespace pg8 {
constexpr int BM = 256, BK = 64, HALF = 128, HTB = HALF * BK * 2, STAGE_BYTES = 8 * HTB;
__host__ __device__ __forceinline__ int lds_byte(int r, int c) { const int st = (r >> 4) * 2 + (c >> 5), rr = r & 15, cc = c & 31, ob = rr * 64 + cc * 2; return st * 1024 + (ob ^ (((ob >> 9) & 1) << 5)); }
__host__ __device__ __forceinline__ void stage_rc(int b, int& R, int& C) { const int st = b / 1024, sb = b % 1024, swz = sb ^ (((sb >> 9) & 1) << 5); R = (st >> 1) * 16 + swz / 64; C = (st & 1) * 32 + (swz % 64) / 2; }
__host__ __device__ __forceinline__ int perm32(int rho) { const int n = rho >> 4, i = rho & 15; return 8 * (i >> 2) + 4 * n + (i & 3); }

struct Unit { int pm, pn, e, j, nrows; };
typedef f32x4 Acc[2][2][4][2];
struct SideCvt { const float* wg; const float* wu; const float* wd; unsigned char* W1; unsigned char* W2; unsigned char* trash; int c, G;
    static constexpr int NT = 32 * 3 * 256;
    __device__ __forceinline__ void tile(int q, const float*& src, unsigned char*& dst) const {
        const int T = q * G + c; src = wg; dst = trash; if (q < 0 || T >= NT) return;
        const int e = T / 768, r = T % 768, kind = r >> 8, t = r & 255, k0 = 64 * (t >> 4), n0 = 64 * (t & 15);
        const float* w = kind == 0 ? wg : kind == 1 ? wu : wd; src = w + (size_t)e * 1024 * 1024 + (size_t)k0 * 1024 + n0;
        dst = kind == 2 ? W2 + ((size_t)e * 1024 + n0) * 1024 + k0 : W1 + ((size_t)e * 2048 + (n0 >> 7) * 256 + kind * 128 + (n0 & 127)) * 1024 + k0; }
};

template <class P, bool ALIGN_EPI>
__device__ __forceinline__ void gemm_phase(LAS unsigned char* lds, const P& p, int wave_) {
    const int tid = my_tid(wave_), wid = wave_, lane = tid & 63, wr = wid >> 2, wc = wid & 3, fr = lane & 15, fq = lane >> 4;
    constexpr int KB = P::K * P::ESZ  , nt = KB / 128; constexpr bool SIDE = P::SIDE;
    unsigned voffB;
    { int R, C; stage_rc(tid * 16, R, C);
        int Rb = R;
        if (P::BMODE == 1) Rb = (R & ~31) + perm32(R & 31);
        if (P::BMODE == 2) Rb = 64 * ((R >> 5) & 3) + perm32(R & 31);
        voffB = (unsigned)(Rb * KB + C * 2); }
    constexpr unsigned bpiece = (unsigned)(P::BMODE == 2 ? 128 : 64) * KB;
    constexpr unsigned kstep = 128u;
    constexpr unsigned bhalf = (unsigned)(P::BMODE == 2 ? 32 : HALF) * KB;
    const __amdgpu_buffer_rsrc_t rA = __builtin_amdgcn_make_buffer_rsrc((void*)p.a_mat(), 0, 0x7fffffff, 0x00020000), rB = __builtin_amdgcn_make_buffer_rsrc((void*)p.b_mat(), 0, 0x7fffffff, 0x00020000);
    const unsigned ldsw = (unsigned)wid * 1024u;
    const int aoff = lds_byte(wr * 64 + fr, fq * 8), boff = lds_byte(wc * 32 + fr, fq * 8);
    LAS unsigned char* ldsA = lds + aoff; LAS unsigned char* ldsB = lds + 65536 + boff; asm volatile("" : "+v"(ldsA), "+v"(ldsB));
#define PG8_SA(b, h) (((b) * 2 + (h)) * HTB)
#define PG8_SB(b, h) ((4 + (b) * 2 + (h)) * HTB)
#define PG8_STAGE_B(bufoff, soff) do { _Pragma("unroll") for (int _i = 0; _i < 2; ++_i) \
        __builtin_amdgcn_raw_ptr_buffer_load_lds(rB, (LAS unsigned*)(lds + (bufoff) + ldsw + _i * 8192), 16, (int)voffB, (int)((soff) + _i * bpiece), 0, 0); } while (0)
#define PG8_STAGE_A(bufoff, soff, h) do { _Pragma("unroll") for (int _i = 0; _i < 2; ++_i) { \
        if constexpr (P::GATHER) __builtin_amdgcn_raw_ptr_buffer_load_lds(rA, (LAS unsigned*)(lds + (bufoff) + ldsw + _i * 8192), 16, (int)voffA[h][_i], (int)(soff), 0, 0); \
        else __builtin_amdgcn_raw_ptr_buffer_load_lds(rA, (LAS unsigned*)(lds + (bufoff) + ldsw + _i * 8192), 16, (int)voffA[0][0], (int)((soff) + (h) * (128u * KB) + _i * (64u * KB)), 0, 0); } } while (0)
#define PG8_LD8(p_) __builtin_shufflevector(*(const LAS i32x4*)(p_), *(const LAS i32x4*)((p_) + 1024), 0, 1, 2, 3, 4, 5, 6, 7)
#define PG8_LDA(dst, b, h) do { if constexpr (P::FP8) { _Pragma("unroll") for (int m = 0; m < 4; ++m) dst##8[m] = PG8_LD8(ldsA + PG8_SA(b, h) + m * 2048); } \
        else { _Pragma("unroll") for (int m = 0; m < 4; ++m) _Pragma("unroll") for (int k = 0; k < 2; ++k) dst[m][k] = *(const LAS bf16x8*)(ldsA + PG8_SA(b, h) + m * 2048 + k * 1024); } } while (0)
#define PG8_LDB(dst, b, h) do { if constexpr (P::FP8) { _Pragma("unroll") for (int n = 0; n < 2; ++n) dst##8[n] = PG8_LD8(ldsB + (PG8_SB(b, h) - 65536) + n * 2048); } \
        else { _Pragma("unroll") for (int n = 0; n < 2; ++n) _Pragma("unroll") for (int k = 0; k < 2; ++k) dst[n][k] = *(const LAS bf16x8*)(ldsB + (PG8_SB(b, h) - 65536) + n * 2048 + k * 1024); } } while (0)
#define PG8_MMA(ai, bj, At, Bt) do { __builtin_amdgcn_s_setprio(1); \
        if constexpr (P::FP8) { _Pragma("unroll") for (int m = 0; m < 4; ++m) _Pragma("unroll") for (int n = 0; n < 2; ++n) \
            acc[ai][bj][m][n] = __builtin_amdgcn_mfma_scale_f32_16x16x128_f8f6f4(Bt##8[n], At##8[m], acc[ai][bj][m][n], 0, 0, 0, 0x7F7F7F7F, 0, 0x7F7F7F7F); } \
        else { _Pragma("unroll") for (int m = 0; m < 4; ++m) _Pragma("unroll") for (int n = 0; n < 2; ++n) _Pragma("unroll") for (int k = 0; k < 2; ++k) \
            acc[ai][bj][m][n] = __builtin_amdgcn_mfma_f32_16x16x32_bf16(Bt[n][k], At[m][k], acc[ai][bj][m][n], 0, 0, 0); } \
        __builtin_amdgcn_s_setprio(0); } while (0)
#define PG8_WAIT_V(n) asm volatile("s_waitcnt vmcnt(" #n ")" ::: "memory")
#define PG8_WAIT_L(n) asm volatile("s_waitcnt lgkmcnt(" #n ")" ::: "memory")
#define PG8_BAR __builtin_amdgcn_s_barrier()
#define PG8_SCHED __builtin_amdgcn_sched_barrier(0)
    Unit cur, nxt; int ui = 0;
    if (!p.next(0, cur)) return;
    Acc acc;
#pragma unroll
    for (int a = 0; a < 2; ++a)
#pragma unroll
        for (int b = 0; b < 2; ++b)
#pragma unroll
            for (int m = 0; m < 4; ++m)
#pragma unroll
                for (int n = 0; n < 2; ++n) acc[a][b][m][n] = (f32x4){0.f, 0.f, 0.f, 0.f};
    bf16x8 At[4][2], B0[2][2], B1[2][2]; i32x8 At8[4], B08[2], B18[2];
    unsigned voffA[2][2]; p.a_voff(cur, voffA, tid);
    LAS int* idxs = (LAS int*)(lds + STAGE_BYTES) + 4 * tid;
    if constexpr (P::GATHER) { Unit u1; if (p.next(1, u1)) { int tk[2][2]; p.a_idx(u1, tk, tid); idxs[0] = tk[0][0]; idxs[1] = tk[0][1]; idxs[2] = tk[1][0]; idxs[3] = tk[1][1]; } }
    const unsigned sv_dma = ((unsigned)(lane >> 4) + 8u * (unsigned)wid) * 4096u + (unsigned)(lane & 15) * 16u;
    LAS const float* sv_rd = (LAS const float*)(lds + STAGE_BYTES + wid * 2048) + lane;
    const unsigned sv_st = (unsigned)lane * 1024u + 8u * (unsigned)wid;
    int sq = 0; u32x2 sv_pk = {0u, 0u};
#define PG8_SIDE_READ() do { if constexpr (SIDE) { float f_[8]; _Pragma("unroll") for (int j_ = 0; j_ < 8; ++j_) f_[j_] = sv_rd[(j_ >> 2) * 256 + (j_ & 3) * 64] * F8_SW; \
        sv_pk.x = pk4_fp8(f_[0], f_[1], f_[2], f_[3]); sv_pk.y = pk4_fp8(f_[4], f_[5], f_[6], f_[7]); } } while (0)
#define PG8_SIDE_STORE() do { if constexpr (SIDE) { const float* s_; unsigned char* d_; p.side.tile(sq - 1, s_, d_); *(u32x2*)(d_ + sv_st) = sv_pk; } } while (0)
#define PG8_SIDE_DMA() do { if constexpr (SIDE) { const float* s_; unsigned char* d_; p.side.tile(sq, s_, d_); \
        const __amdgpu_buffer_rsrc_t rS_ = __builtin_amdgcn_make_buffer_rsrc((void*)s_, 0, 0x7fffffff, 0x00020000); \
        _Pragma("unroll") for (int _i = 0; _i < 2; ++_i) __builtin_amdgcn_raw_ptr_buffer_load_lds(rS_, (LAS unsigned*)(lds + STAGE_BYTES + wid * 2048 + _i * 1024), 16, (int)sv_dma, _i * 4 * 4096, 0, 2); } } while (0)
    unsigned cA = p.a_off(cur), cB = p.b_off(cur);
#ifndef KLOOP8
#define KLOOP8 0
#endif
#if KLOOP8
    PG8_STAGE_B(PG8_SB(0, 0), cB); PG8_STAGE_A(PG8_SA(0, 0), cA, 0); PG8_STAGE_B(PG8_SB(0, 1), cB + bhalf); PG8_STAGE_A(PG8_SA(0, 1), cA, 1);
    if (wr == 1) PG8_BAR;
    PG8_WAIT_V(4); PG8_BAR;
#else
    PG8_STAGE_B(PG8_SB(0, 0), cB); PG8_STAGE_B(PG8_SB(0, 1), cB + bhalf); PG8_STAGE_A(PG8_SA(0, 0), cA, 0); PG8_STAGE_A(PG8_SA(0, 1), cA, 1);
    if (wr == 1) PG8_BAR;
    PG8_WAIT_V(2); PG8_BAR;
#endif
    PG8_STAGE_B(PG8_SB(1, 0), cB + kstep); PG8_STAGE_A(PG8_SA(1, 0), cA + kstep, 0); PG8_STAGE_B(PG8_SB(1, 1), cB + bhalf + kstep);
    PG8_WAIT_V(6); PG8_BAR;
    for (;;) {
        const bool has_next = p.next(ui + 1, nxt);
        const unsigned nA = has_next ? p.a_off(nxt) : cA, nB = has_next ? p.b_off(nxt) : cB;
#pragma unroll 1
        for (int t = 0; t < nt; t += 2) {
            const bool last = (t == nt - 2);
            const unsigned a1 = cA + (unsigned)(t + 1) * kstep;
            const unsigned a2 = last ? nA : cA + (unsigned)(t + 2) * kstep, b2 = last ? nB : cB + (unsigned)(t + 2) * kstep;
            const unsigned a3 = a2 + kstep, b3 = b2 + kstep;
#if KLOOP8
            PG8_LDB(B0, 0, 0); PG8_SCHED; PG8_LDA(At, 0, 0); PG8_STAGE_A(PG8_SA(1, 1), a1, 1);
            if constexpr (P::GATHER) { if (last && has_next) { const int t_ = my_tid(wave_); LAS const int* ix = (LAS const int*)(lds + STAGE_BYTES) + 4 * t_; const int tk[2][2] = {{ix[0], ix[1]}, {ix[2], ix[3]}}; p.a_voff_from(tk, voffA, t_); } }
            PG8_WAIT_L(8); PG8_BAR; PG8_WAIT_L(0); PG8_MMA(0, 0, At, B0); PG8_BAR; PG8_SCHED;
            PG8_LDB(B1, 0, 1); PG8_STAGE_B(PG8_SB(0, 0), b2);
            PG8_BAR; PG8_WAIT_L(0); PG8_MMA(0, 1, At, B1); PG8_BAR;
            PG8_LDA(At, 0, 1); PG8_STAGE_A(PG8_SA(0, 0), a2, 0);
            PG8_BAR; PG8_WAIT_L(0); PG8_MMA(1, 0, At, B0); PG8_BAR; PG8_SCHED;
            PG8_STAGE_B(PG8_SB(0, 1), b2 + bhalf);
            PG8_WAIT_V(6); PG8_BAR; PG8_MMA(1, 1, At, B1); PG8_BAR;
            PG8_LDB(B0, 1, 0); PG8_SCHED; PG8_LDA(At, 1, 0); PG8_STAGE_A(PG8_SA(0, 1), a2, 1);
            PG8_WAIT_L(8); PG8_BAR; PG8_WAIT_L(0); PG8_MMA(0, 0, At, B0); PG8_BAR; PG8_SCHED;
            PG8_LDB(B1, 1, 1); PG8_STAGE_B(PG8_SB(1, 0), b3);
            PG8_BAR; PG8_WAIT_L(0); PG8_MMA(0, 1, At, B1); PG8_BAR;
            PG8_LDA(At, 1, 1); PG8_STAGE_A(PG8_SA(1, 0), a3, 0);
            PG8_BAR; PG8_WAIT_L(0); PG8_MMA(1, 0, At, B0); PG8_BAR; PG8_SCHED;
            PG8_STAGE_B(PG8_SB(1, 1), b3 + bhalf);
            PG8_WAIT_V(6); PG8_BAR; PG8_MMA(1, 1, At, B1); PG8_BAR;
#else
            PG8_LDB(B0, 0, 0); PG8_LDB(B1, 0, 1); PG8_SCHED; PG8_LDA(At, 0, 0); PG8_STAGE_A(PG8_SA(1, 1), a1, 1); PG8_SIDE_READ();
            if constexpr (P::GATHER) { if (last && has_next) { const int t_ = my_tid(wave_); LAS const int* ix = (LAS const int*)(lds + STAGE_BYTES) + 4 * t_; const int tk[2][2] = {{ix[0], ix[1]}, {ix[2], ix[3]}}; p.a_voff_from(tk, voffA, t_); } }
            PG8_WAIT_V(8); PG8_WAIT_L(0); PG8_BAR; PG8_MMA(0, 0, At, B0); PG8_MMA(0, 1, At, B1); PG8_BAR; PG8_SCHED;
            PG8_LDA(At, 0, 1); PG8_SIDE_STORE(); PG8_STAGE_B(PG8_SB(0, 0), b2); PG8_STAGE_B(PG8_SB(0, 1), b2 + bhalf); PG8_STAGE_A(PG8_SA(0, 0), a2, 0); PG8_SIDE_DMA();
            if constexpr (SIDE) { PG8_WAIT_V(11); } else { PG8_WAIT_V(8); } PG8_WAIT_L(0); PG8_BAR; PG8_MMA(1, 0, At, B0); PG8_MMA(1, 1, At, B1); PG8_BAR; PG8_SCHED;
            PG8_LDB(B0, 1, 0); PG8_LDB(B1, 1, 1); PG8_SCHED; PG8_LDA(At, 1, 0); PG8_STAGE_A(PG8_SA(0, 1), a2, 1);
            if constexpr (SIDE) { PG8_WAIT_V(11); } else { PG8_WAIT_V(8); } PG8_WAIT_L(0); PG8_BAR; PG8_MMA(0, 0, At, B0); PG8_MMA(0, 1, At, B1); PG8_BAR; PG8_SCHED;
            PG8_LDA(At, 1, 1); PG8_STAGE_B(PG8_SB(1, 0), b3); PG8_STAGE_B(PG8_SB(1, 1), b3 + bhalf); PG8_STAGE_A(PG8_SA(1, 0), a3, 0);
            PG8_WAIT_V(8); PG8_WAIT_L(0); PG8_BAR; PG8_MMA(1, 0, At, B0); PG8_MMA(1, 1, At, B1); PG8_BAR; PG8_SCHED;
            if constexpr (SIDE) ++sq;
#endif
        }
        if constexpr (ALIGN_EPI) { if (wr == 0) PG8_BAR; }
        { int tz = my_tid(wave_); asm volatile("" : "+v"(tz));
          const int wz = wave_; int tk2[2][2] = {{0, 0}, {0, 0}}; bool h2 = false;
          if constexpr (P::GATHER) { Unit u2; h2 = has_next && p.next(ui + 2, u2); if (h2) p.a_idx(u2, tk2, tz); }
          p.epi(acc, cur, wz >> 2, wz & 3, tz & 15, (tz >> 4) & 3);
          if constexpr (P::GATHER) { if (h2) { LAS int* ix = (LAS int*)(lds + STAGE_BYTES) + 4 * tz; ix[0] = tk2[0][0]; ix[1] = tk2[0][1]; ix[2] = tk2[1][0]; ix[3] = tk2[1][1]; } } }
        if (!has_next) break;
#pragma unroll
        for (int a = 0; a < 2; ++a)
#pragma unroll
            for (int b = 0; b < 2; ++b)
#pragma unroll
                for (int m = 0; m < 4; ++m)
#pragma unroll
                    for (int n = 0; n < 2; ++n) acc[a][b][m][n] = (f32x4){0.f, 0.f, 0.f, 0.f};
        cur = nxt; cA = nA; cB = nB; ++ui;
        if constexpr (ALIGN_EPI) { if (wr == 1) PG8_BAR; }
    }
    PG8_WAIT_V(0);
    if constexpr (!ALIGN_EPI) { if (wr == 0) PG8_BAR; }
    PG8_BAR;
    if constexpr (SIDE) {
        PG8_SIDE_READ(); PG8_SIDE_STORE();
        for (;;) { const float* s_; unsigned char* d_; if ((long)sq * p.side.G + p.side.c >= SideCvt::NT) break;
            PG8_SIDE_DMA(); PG8_WAIT_V(0); ++sq; PG8_SIDE_READ(); PG8_SIDE_STORE(); PG8_WAIT_L(0); (void)s_; (void)d_; }
        PG8_WAIT_V(0); PG8_BAR; }
#undef PG8_SIDE_READ
#undef PG8_SIDE_STORE
#undef PG8_SIDE_DMA
#undef PG8_SA
#undef PG8_SB
#undef PG8_STAGE_A
#undef PG8_STAGE_B
#undef PG8_LDA
#undef PG8_LDB
#undef PG8_MMA
#undef PG8_LD8
#undef PG8_WAIT_V
#undef PG8_WAIT_L
#undef PG8_BAR
#undef PG8_SCHED
}
struct StaticOrder {
    int nM, nN, nwg, G, c, i0, i1;
    __device__ void init(int M, int N, int G_, int c_) { nM = M / BM; nN = N / BM; nwg = nM * nN; G = G_; c = c_; i0 = 0; i1 = 1 << 30; }
    __device__ bool next(int i, int& pm, int& pn) const {
        i += i0; if (i >= i1) return false;
        const long L = (long)i * G + c; if (L >= nwg) return false;
        int wgid = (int)L; { const int q = nwg / 8, r = nwg % 8, xcd = wgid % 8, off = wgid / 8; wgid = (xcd < r ? xcd * (q + 1) : r * (q + 1) + (xcd - r) * q) + off; }
        const int nig = 8 * nN, gid = wgid / nig, fm = gid * 8, gsz = (nM - fm) < 8 ? (nM - fm) : 8;
        pm = fm + ((wgid % nig) % gsz); pn = (wgid % nig) / gsz; return true;
    }
};
}
using pg8::Unit; using pg8::Acc; using pg8::SideCvt;


struct DenseBase {
    static constexpr bool SIDE = false;
    const char* A; const char* Bt; pg8::StaticOrder S;
    __device__ __forceinline__ bool next(int i, Unit& u) const { u.e = 0; u.j = 0; u.nrows = 256; return S.next(i, u.pm, u.pn); }
};
template <int K_, bool F8_ = false> struct DenseAddr : DenseBase {
    static constexpr int K = K_, ESZ = F8_ ? 1 : 2, KB = K * ESZ; static constexpr bool GATHER = false, FP8 = F8_;
    __device__ __forceinline__ const char* a_mat() const { return A; }
    __device__ __forceinline__ const char* b_mat() const { return Bt; }
    __device__ __forceinline__ unsigned a_off(const Unit& u) const { return (unsigned)u.pm * (256u * KB); }
    __device__ __forceinline__ unsigned b_off(const Unit& u) const { return (unsigned)u.pn * (256u * KB); }
    __device__ __forceinline__ void a_voff(const Unit&, unsigned (&v)[2][2], int tid_) const {
#pragma unroll
        for (int i = 0; i < 2; ++i) { int R, C; pg8::stage_rc(tid_ * 16 + i * 8192, R, C);
#pragma unroll
            for (int h = 0; h < 2; ++h) v[h][i] = (unsigned)((h * 128 + R) * KB + C * 2); } }
};
struct ProbSguIn : DenseAddr<1024, SGU1_FP8 != 0> {
    static constexpr int BMODE = 1;
    const float* bias; bf16* U; bf16* V; float* vpart;
    static constexpr bool SIDE = (MOE1_FP8 != 0) && (MOE2_FP8 != 0) && (SGU1_FP8 == 0); SideCvt side;
    __device__ __forceinline__ void epi(Acc& acc, const Unit& u, int wr, int wc, int fr, int fq) const {
#ifdef EPI2_P2
        _Pragma("unroll 1") for (int rep2 = 0; rep2 < 2; ++rep2) { asm volatile("" ::: "memory");
#else
        {
#endif
        const bool isv = u.pn >= 12; bf16* O = isv ? V : U; const int colt = (isv ? u.pn - 12 : u.pn) * 256 + wc * 32 + 8 * fq, bcol = u.pn * 256 + wc * 32 + 8 * fq;
        f32x4 bv[2][2];
#pragma unroll
        for (int bj = 0; bj < 2; ++bj)
#pragma unroll
            for (int n = 0; n < 2; ++n) bv[bj][n] = *(const f32x4*)(bias + bcol + bj * 128 + 4 * n);
#pragma unroll
        for (int ai = 0; ai < 2; ++ai)
#pragma unroll
            for (int m = 0; m < 4; ++m) { const int row = u.pm * 256 + ai * 128 + wr * 64 + m * 16 + fr; bf16* rowp = O + (size_t)row * DS + colt; float ss = 0.f;
#pragma unroll
                for (int bj = 0; bj < 2; ++bj) { constexpr float SC = SGU1_FP8 ? 1.0f / (F8_SH * F8_SW) : 1.0f; f32x4 v0 = acc[ai][bj][m][0] * SC + bv[bj][0], v1 = acc[ai][bj][m][1] * SC + bv[bj][1];
#pragma unroll
                    for (int j = 0; j < 4; j += 2) { const f32x2 a = gelu_tanh2((f32x2){v0[j], v0[j + 1]}), b = gelu_tanh2((f32x2){v1[j], v1[j + 1]}); v0[j] = a.x; v0[j + 1] = a.y; v1[j] = b.x; v1[j + 1] = b.y;
                        ss += (a.x * a.x + a.y * a.y) + (b.x * b.x + b.y * b.y); }
                    u32x4 w; w.x = cvt_pk_bf16(v0[0], v0[1]); w.y = cvt_pk_bf16(v0[2], v0[3]); w.z = cvt_pk_bf16(v1[0], v1[1]); w.w = cvt_pk_bf16(v1[2], v1[3]);
                    *(u32x4*)(rowp + bj * 128) = w; }
                if (isv) { ss += __shfl_xor(ss, 16); ss += __shfl_xor(ss, 32); if (fq == 0) vpart[(size_t)row * 48 + (u.pn - 12) * 4 + wc] = ss; } }
        }
    }
};
template <int K_, bool XIN16_> struct ProbResid : DenseAddr<K_> {
    static constexpr int BMODE = 1;
    const void* xin; bf16* xout; const float* gate;
    __device__ __forceinline__ void epi(Acc& acc, const Unit& u, int wr, int wc, int fr, int fq) const {
        const int col0 = u.pn * 256 + wc * 32 + 8 * fq; const int b = (u.pm * 256) / SEQ;
        f32x4 gv[2][2];
#pragma unroll
        for (int bj = 0; bj < 2; ++bj)
#pragma unroll
            for (int n = 0; n < 2; ++n) gv[bj][n] = *(const f32x4*)(gate + (size_t)b * 6144 + col0 + bj * 128 + 4 * n);
#pragma unroll
        for (int ai = 0; ai < 2; ++ai)
#pragma unroll
            for (int m = 0; m < 4; ++m) { const size_t off = (size_t)(u.pm * 256 + ai * 128 + wr * 64 + m * 16 + fr) * DM + col0;
#pragma unroll
                for (int bj = 0; bj < 2; ++bj) { f32x4 x0, x1;
                    if constexpr (XIN16_) { const u32x4 w = *(const u32x4*)((const bf16*)xin + off + bj * 128);
                        x0 = (f32x4){bf2f(w.x & 0xffffu), bf2f(w.x >> 16), bf2f(w.y & 0xffffu), bf2f(w.y >> 16)}; x1 = (f32x4){bf2f(w.z & 0xffffu), bf2f(w.z >> 16), bf2f(w.w & 0xffffu), bf2f(w.w >> 16)}; }
                    else { x0 = *(const f32x4*)((const float*)xin + off + bj * 128); x1 = *(const f32x4*)((const float*)xin + off + bj * 128 + 4); }
                    const f32x4 v0 = x0 + gv[bj][0] * acc[ai][bj][m][0], v1 = x1 + gv[bj][1] * acc[ai][bj][m][1];
                    u32x4 o; o.x = cvt_pk_bf16(v0[0], v0[1]); o.y = cvt_pk_bf16(v0[2], v0[3]); o.z = cvt_pk_bf16(v1[0], v1[1]); o.w = cvt_pk_bf16(v1[2], v1[3]);
                    *(u32x4*)(xout + off + bj * 128) = o; } }
    }
};
struct ProbHead : DenseBase {
    static constexpr int K = 1024, ESZ = 2; static constexpr bool GATHER = false, FP8 = false; static constexpr int BMODE = 2;
    const char* A2; const char* Bt2;
    const float* kg; const float* qg; bf16* Kb; bf16* Vb; bf16* Qb; float* kmean;
    __device__ __forceinline__ const char* a_mat() const { return A; }
    __device__ __forceinline__ const char* b_mat() const { return Bt; }
    __device__ __forceinline__ unsigned a_off(const Unit& u) const { return (u.pn >= 8 ? (unsigned)(A2 - A) : 0u) + (unsigned)u.pm * (256u * K * 2); }
    __device__ __forceinline__ unsigned b_off(const Unit& u) const { return u.pn >= 8 ? (unsigned)(Bt2 - Bt) + (unsigned)(u.pn - 8) * (256u * K * 2) : (unsigned)u.pn * (256u * K * 2); }
    __device__ __forceinline__ void a_voff(const Unit&, unsigned (&v)[2][2], int tid_) const {
#pragma unroll
        for (int i = 0; i < 2; ++i) { int R, C; pg8::stage_rc(tid_ * 16 + i * 8192, R, C);
#pragma unroll
            for (int h = 0; h < 2; ++h) v[h][i] = (unsigned)((h * 128 + R) * K + C) * 2u; } }
    __device__ __forceinline__ void epi(Acc& acc, const Unit& u, int wr, int wc, int fr, int fq) const {
        const int kind = u.pn >= 8 ? 2 : (u.pn >= 4 ? 1 : 0);
        const int head = (kind == 0 ? u.pn : kind == 1 ? u.pn - 4 : u.pn - 8) * 4 + wc;
        bf16* O = kind == 0 ? Kb : kind == 1 ? Vb : Qb; const float* g = kind == 2 ? qg : kg;
        f32x4 gv[2][2];
#pragma unroll
        for (int bj = 0; bj < 2; ++bj)
#pragma unroll
            for (int n = 0; n < 2; ++n) gv[bj][n] = *(const f32x4*)(g + 32 * bj + 8 * fq + 4 * n);
        f32x4 ksum[2][2];
#pragma unroll
        for (int bj = 0; bj < 2; ++bj)
#pragma unroll
            for (int n = 0; n < 2; ++n) ksum[bj][n] = (f32x4){0.f, 0.f, 0.f, 0.f};
#pragma unroll
        for (int ai = 0; ai < 2; ++ai)
#pragma unroll
            for (int m = 0; m < 4; ++m) { const int row = u.pm * 256 + ai * 128 + wr * 64 + m * 16 + fr; float rstd = 1.0f;
                if (kind != 1) { float ss = 0.f;
#pragma unroll
                    for (int bj = 0; bj < 2; ++bj)
#pragma unroll
                        for (int n = 0; n < 2; ++n) { const f32x4 x = acc[ai][bj][m][n]; ss += (x[0] * x[0] + x[1] * x[1]) + (x[2] * x[2] + x[3] * x[3]); }
                    ss += __shfl_xor(ss, 16); ss += __shfl_xor(ss, 32); rstd = rsqrtf(ss * (1.0f / HD) + EPS); }
#pragma unroll
                for (int bj = 0; bj < 2; ++bj) { f32x4 v0 = acc[ai][bj][m][0], v1 = acc[ai][bj][m][1];
                    if (kind != 1) { v0 = v0 * rstd * gv[bj][0]; v1 = v1 * rstd * gv[bj][1]; }
                    if (kind == 2) { v0 = v0 * QSCALE; v1 = v1 * QSCALE; }
                    if (kind == 0) { ksum[bj][0] += v0; ksum[bj][1] += v1; }
                    if (kind == 1 && m >= 2) { const float k32 = __builtin_amdgcn_exp2f(32.f * 1.4426950408889634f * __builtin_amdgcn_exp2f(-0.5f * (float)(head + 1))); v0 = v0 * k32; v1 = v1 * k32; }
                    u32x4 w; w.x = cvt_pk_bf16(v0[0], v0[1]); w.y = cvt_pk_bf16(v0[2], v0[3]); w.z = cvt_pk_bf16(v1[0], v1[1]); w.w = cvt_pk_bf16(v1[2], v1[3]);
                    *(u32x4*)(O + (size_t)row * DM + head * HD + 32 * bj + 8 * fq) = w; } }
        if (kind == 0) {
            const int b = (u.pm * 256) / SEQ, blk = u.pm & 15;
#pragma unroll
            for (int bj = 0; bj < 2; ++bj)
#pragma unroll
                for (int n = 0; n < 2; ++n)
#pragma unroll
                    for (int j = 0; j < 4; ++j) { float s = ksum[bj][n][j]; s += __shfl_xor(s, 1); s += __shfl_xor(s, 2); s += __shfl_xor(s, 4); s += __shfl_xor(s, 8);
                        if (fr == 0) atomicAdd(kmean + ((size_t)((b * NH + head) * 16 + blk)) * HD + 32 * bj + 8 * fq + 4 * n + j, s); }
        }
    }
};
struct MoeSched {
    const LAS int* tab; int NN, G, c;
    __device__ __forceinline__ bool next(int i, Unit& u) const {
        const long L = (long)i * G + c; const int T = (int)(L / NN);
        const int tsl = tab[lane_id() & 31];
        const int total = __builtin_amdgcn_readfirstlane(tab[32]); if (T >= total) return false;
        const unsigned long long bal = __ballot(tsl <= T) & 0xffffffffull;
        const int e = __builtin_popcountll(bal) - 1;
        const int ts = __builtin_amdgcn_readlane(tsl, e), cn = __builtin_amdgcn_readfirstlane(tab[33 + e]);
        u.pm = T; u.pn = (int)(L % NN); u.e = e; u.j = T - ts; const int rem = cn - 256 * u.j; u.nrows = rem < 256 ? rem : 256; return true;
    }
};
struct ProbMoe1 {
    static constexpr int K = 1024, BMODE = 1, ESZ = MOE1_FP8 ? 1 : 2, KB = K * ESZ, OKB = K * (MOE2_FP8 ? 1 : 2); static constexpr bool GATHER = true, FP8 = MOE1_FP8 != 0, OUT8 = MOE2_FP8 != 0, SIDE = false;
    MoeSched S; const char* H; const char* W1; const int* rowt; const float* bg; const float* bu; unsigned char* Abuf;
    __device__ __forceinline__ bool next(int i, Unit& u) const { return S.next(i, u); }
    __device__ __forceinline__ const char* a_mat() const { return H; }
    __device__ __forceinline__ const char* b_mat() const { return W1; }
    __device__ __forceinline__ unsigned a_off(const Unit&) const { return 0u; }
    __device__ __forceinline__ unsigned b_off(const Unit& u) const { return ((unsigned)u.e * 2048u + (unsigned)u.pn * 256u) * KB; }
    __device__ __forceinline__ void a_idx(const Unit& u, int (&tk)[2][2], int tid_) const {
#pragma unroll
        for (int i = 0; i < 2; ++i) { int R, C; pg8::stage_rc(tid_ * 16 + i * 8192, R, C);
#pragma unroll
            for (int h = 0; h < 2; ++h) { const int r = h * 128 + R; tk[h][i] = rowt[u.e * CAP + u.j * 256 + (r < u.nrows ? r : 0)]; } } }
    __device__ __forceinline__ void a_voff_from(const int (&tk)[2][2], unsigned (&v)[2][2], int tid_) const {
#pragma unroll
        for (int i = 0; i < 2; ++i) { int R, C; pg8::stage_rc(tid_ * 16 + i * 8192, R, C);
#pragma unroll
            for (int h = 0; h < 2; ++h) v[h][i] = (unsigned)((tk[h][i] >> 2) * KB + C * 2); } }
    __device__ __forceinline__ void a_voff(const Unit& u, unsigned (&v)[2][2], int tid_) const { int tk[2][2]; a_idx(u, tk, tid_); a_voff_from(tk, v, tid_); }
    __device__ __forceinline__ void epi(Acc& acc, const Unit& u, int wr, int wc, int fr, int fq) const {
        const int jo = u.pn * 128 + wc * 32 + 8 * fq;
        f32x4 bgv[2], buv[2];
#pragma unroll
        for (int n = 0; n < 2; ++n) { bgv[n] = *(const f32x4*)(bg + u.e * DM + jo + 4 * n); buv[n] = *(const f32x4*)(bu + u.e * DM + jo + 4 * n); }
#pragma unroll
        for (int ai = 0; ai < 2; ++ai)
#pragma unroll
            for (int m = 0; m < 4; ++m) { const int r = ai * 128 + wr * 64 + m * 16 + fr; f32x4 o[2];
#pragma unroll
                for (int n = 0; n < 2; ++n) { constexpr float SC = FP8 ? 1.0f / (F8_SH * F8_SW) : 1.0f, SO = OUT8 ? F8_SA : 1.0f;
#pragma unroll
                    for (int j = 0; j < 4; j += 2) {
                        const f32x2 ga = (f32x2){acc[ai][0][m][n][j], acc[ai][0][m][n][j + 1]} * SC + (f32x2){bgv[n][j], bgv[n][j + 1]}, ua = (f32x2){acc[ai][1][m][n][j], acc[ai][1][m][n][j + 1]} * SC + (f32x2){buv[n][j], buv[n][j + 1]};
                        f32x2 g, uu; g.x = fminf(ga.x, 7.0f); g.y = fminf(ga.y, 7.0f); uu.x = __builtin_amdgcn_fmed3f(ua.x, -7.0f, 7.0f); uu.y = __builtin_amdgcn_fmed3f(ua.y, -7.0f, 7.0f);
                        const f32x2 t = g * (-1.702f * 1.4426950408889634f); f32x2 e; e.x = __builtin_amdgcn_exp2f(t.x); e.y = __builtin_amdgcn_exp2f(t.y);
                        const f32x2 d = e + 1.0f; f32x2 rr; rr.x = fast_rcp(d.x); rr.y = fast_rcp(d.y);
                        const f32x2 ov = (g * rr) * (uu * SO + SO);
                        o[n][j] = ov.x; o[n][j + 1] = ov.y; } }
                if constexpr (OUT8) { u32x2 w; w.x = pk4_fp8_nc(o[0][0], o[0][1], o[0][2], o[0][3]); w.y = pk4_fp8_nc(o[1][0], o[1][1], o[1][2], o[1][3]);
                    *(u32x2*)(Abuf + (size_t)(u.pm * 256 + r) * OKB + jo) = w; }
                else { u32x4 w; w.x = cvt_pk_bf16(o[0][0], o[0][1]); w.y = cvt_pk_bf16(o[0][2], o[0][3]); w.z = cvt_pk_bf16(o[1][0], o[1][1]); w.w = cvt_pk_bf16(o[1][2], o[1][3]);
                    *(u32x4*)(Abuf + (size_t)(u.pm * 256 + r) * OKB + jo * 2) = w; } }
    }
};
struct ProbMoe2 {
    static constexpr int K = 1024, BMODE = 1, ESZ = MOE2_FP8 ? 1 : 2, KB = K * ESZ; static constexpr bool GATHER = false, FP8 = MOE2_FP8 != 0, SIDE = false;
    MoeSched S; const char* Abuf; const char* W2; const int* rowt; const float* rowp; const float* bd; bf16* Y; bf16* trash;
    __device__ __forceinline__ bool next(int i, Unit& u) const { return S.next(i, u); }
    __device__ __forceinline__ const char* a_mat() const { return Abuf; }
    __device__ __forceinline__ const char* b_mat() const { return W2; }
    __device__ __forceinline__ unsigned a_off(const Unit& u) const { return (unsigned)u.pm * (256u * KB); }
    __device__ __forceinline__ unsigned b_off(const Unit& u) const { return ((unsigned)u.e * 1024u + (unsigned)u.pn * 256u) * KB; }
    __device__ __forceinline__ void a_voff(const Unit&, unsigned (&v)[2][2], int tid_) const {
#pragma unroll
        for (int i = 0; i < 2; ++i) { int R, C; pg8::stage_rc(tid_ * 16 + i * 8192, R, C);
#pragma unroll
            for (int h = 0; h < 2; ++h) v[h][i] = (unsigned)((h * 128 + R) * KB + C * 2); } }
    __device__ __forceinline__ void epi(Acc& acc, const Unit& u, int wr, int wc, int fr, int fq) const {
        const int col0 = u.pn * 256 + wc * 32 + 8 * fq;
        f32x4 bv[2][2];
#pragma unroll
        for (int bj = 0; bj < 2; ++bj)
#pragma unroll
            for (int n = 0; n < 2; ++n) bv[bj][n] = *(const f32x4*)(bd + u.e * DM + col0 + bj * 128 + 4 * n);
        int tk[2][4]; float pr[2][4];
#pragma unroll
        for (int ai = 0; ai < 2; ++ai)
#pragma unroll
            for (int m = 0; m < 4; ++m) { const int r = ai * 128 + wr * 64 + m * 16 + fr; const int slot = u.e * CAP + u.j * 256 + (r < u.nrows ? r : 0); tk[ai][m] = rowt[slot]; pr[ai][m] = rowp[slot]; }
#pragma unroll
        for (int ai = 0; ai < 2; ++ai)
#pragma unroll
            for (int m = 0; m < 4; ++m) { const int r = ai * 128 + wr * 64 + m * 16 + fr;
                const bool valid = r < u.nrows; const int tokk = tk[ai][m]; const float pp = pr[ai][m];
                constexpr int YES = Y_FP8 ? 1 : 2; unsigned char* dst = valid ? (unsigned char*)Y + (size_t)tokk * DM * YES : (unsigned char*)trash;
#pragma unroll
                for (int bj = 0; bj < 2; ++bj) { constexpr float SC = FP8 ? 1.0f / (F8_SA * F8_SW) : 1.0f; const float ps = Y_FP8 ? pp * F8_SY : pp;
                    f32x4 v0, v1;
#pragma unroll
                    for (int j = 0; j < 4; j += 2) { const f32x2 a0 = ((f32x2){acc[ai][bj][m][0][j], acc[ai][bj][m][0][j + 1]} * SC + (f32x2){bv[bj][0][j], bv[bj][0][j + 1]}) * ps, a1 = ((f32x2){acc[ai][bj][m][1][j], acc[ai][bj][m][1][j + 1]} * SC + (f32x2){bv[bj][1][j], bv[bj][1][j + 1]}) * ps;
                        v0[j] = a0.x; v0[j + 1] = a0.y; v1[j] = a1.x; v1[j + 1] = a1.y; }
                    if constexpr (Y_FP8 != 0) { u32x2 w; w.x = pk4_fp8(v0[0], v0[1], v0[2], v0[3]); w.y = pk4_fp8(v1[0], v1[1], v1[2], v1[3]); *(u32x2*)(dst + col0 + bj * 128) = w; }
                    else { u32x4 w; w.x = cvt_pk_bf16(v0[0], v0[1]); w.y = cvt_pk_bf16(v0[2], v0[3]); w.z = cvt_pk_bf16(v1[0], v1[1]); w.w = cvt_pk_bf16(v1[2], v1[3]);
                        *(u32x4*)(dst + (col0 + bj * 128) * 2) = w; } } }
    }
};

#define SBAR() __builtin_amdgcn_sched_barrier(0)
namespace attn_body {
using bf16=unsigned short;
using bf16x8=__attribute__((ext_vector_type(8)))short;
using s16x4=__attribute__((ext_vector_type(4)))short;
using f32x16=__attribute__((ext_vector_type(16)))float;
using u32x4=__attribute__((ext_vector_type(4)))unsigned;
constexpr int BATCH=8,NHEAD=16,SEQ=4096,D=64,DM=NHEAD*D;
constexpr int NW=8,QBLK=32,QB=QBLK*NW,KVBLK=64,NQB=SEQ/QB;
constexpr int ATTN_PITCH=DM, ATTN_UNIT_ROWS=QB;
__device__ __forceinline__ int crow(int r,int hi){return (r&3)+8*(r>>2)+4*hi;}
#define SBAR() __builtin_amdgcn_sched_barrier(0)
__device__ __forceinline__ void cmask(f32x16&p0,f32x16&p1,int jb,int qrel,int hi){
  const float NEG=-INFINITY; int kb=64*jb+4*hi;
  #pragma unroll
  for(int r=0;r<16;++r){int kv=kb+(r&3)+8*(r>>2); if(kv>qrel)p0[r]=NEG; if(kv+32>qrel)p1[r]=NEG;}
}

constexpr int NSLOT=3, SLOTB=8192;
constexpr int LDS_K=0, LDS_V=NSLOT*SLOTB, LDS_WS=2*NSLOT*SLOTB, LDS_OST=LDS_WS+NW*64*4, LDS_KMS=LDS_OST+NW*4096, LDS_BYTES=LDS_KMS+4096;
constexpr float C2=0.125f*1.4426950408889634f;
__device__ __forceinline__ void glds16(const void*gsrc,unsigned lds_dst){unsigned keep;
  asm volatile("s_mov_b32 %0, m0\n\ts_mov_b32 m0, %2\n\ts_nop 0\n\tglobal_load_lds_dwordx4 %1, off\n\ts_mov_b32 m0, %0":"=&s"(keep):"v"(gsrc),"s"(lds_dst):"memory");}
__device__ __forceinline__ float max3f(float a,float b,float c){float r;asm("v_max3_f32 %0, %1, %2, %3":"=v"(r):"v"(a),"v"(b),"v"(c));return r;}
__device__ __forceinline__ float max2f(float a,float b){float r;asm("v_max_f32_e32 %0, %1, %2":"=v"(r):"v"(a),"v"(b));return r;}
__device__ __forceinline__ float fadd_s(float a,float b){float r;asm("v_add_f32_e32 %0, %1, %2":"=v"(r):"v"(a),"v"(b));return r;}
__device__ __forceinline__ float fsub_s(float a,float b){float r;asm("v_sub_f32_e32 %0, %1, %2":"=v"(r):"v"(a),"v"(b));return r;}
typedef float f32x2_t __attribute__((ext_vector_type(2))); typedef float f32x4_t __attribute__((ext_vector_type(4))); constexpr float MFIX=8.0f; typedef __bf16 bf16x2_t __attribute__((ext_vector_type(2)));
__device__ __forceinline__ unsigned cvtpk_s(float lo,float hi){f32x2_t v={lo,hi};bf16x2_t b=__builtin_convertvector(v,bf16x2_t);return __builtin_bit_cast(unsigned,b);}
#define WAIT_BAR(N) asm volatile("s_waitcnt vmcnt(" #N ") lgkmcnt(0)\n\ts_barrier":::"memory")

__device__ __forceinline__ void qkt(f32x16&p0,f32x16&p1,const char*Kslot,const bf16x8*qr,const f32x16&cin,int r32,int hi){
  const char*kb=Kslot+hi*1024+r32*16;
  #pragma unroll
  for(int d0=0;d0<4;++d0){
    const bf16x8 b0=*reinterpret_cast<const bf16x8*>(kb+d0*2048);
    const bf16x8 b1=*reinterpret_cast<const bf16x8*>(kb+d0*2048+512);
    if(d0==0){p0=__builtin_amdgcn_mfma_f32_32x32x16_bf16(b0,qr[0],cin,0,0,0);p1=__builtin_amdgcn_mfma_f32_32x32x16_bf16(b1,qr[0],cin,0,0,0);}
    else{p0=__builtin_amdgcn_mfma_f32_32x32x16_bf16(b0,qr[d0],p0,0,0,0);p1=__builtin_amdgcn_mfma_f32_32x32x16_bf16(b1,qr[d0],p1,0,0,0);}}
}
typedef __attribute__((address_space(3))) const char* lds_cptr;
typedef short v4i16_t __attribute__((ext_vector_type(4)));
__device__ __forceinline__ void kload8(bf16x8*kf,lds_cptr kp){
  kf[0]=*(const __attribute__((address_space(3))) bf16x8*)(kp);      kf[1]=*(const __attribute__((address_space(3))) bf16x8*)(kp+512);
  kf[2]=*(const __attribute__((address_space(3))) bf16x8*)(kp+2048); kf[3]=*(const __attribute__((address_space(3))) bf16x8*)(kp+2560);
  kf[4]=*(const __attribute__((address_space(3))) bf16x8*)(kp+4096); kf[5]=*(const __attribute__((address_space(3))) bf16x8*)(kp+4608);
  kf[6]=*(const __attribute__((address_space(3))) bf16x8*)(kp+6144); kf[7]=*(const __attribute__((address_space(3))) bf16x8*)(kp+6656);
}
__device__ __forceinline__ void kload2(bf16x8*kf,lds_cptr kp,int j){ kf[2*j]=*(const __attribute__((address_space(3))) bf16x8*)(kp+j*2048); kf[2*j+1]=*(const __attribute__((address_space(3))) bf16x8*)(kp+j*2048+512); }
__device__ __forceinline__ s16x4 vtr(lds_cptr p){ return __builtin_bit_cast(s16x4,__builtin_amdgcn_ds_read_tr16_b64_v4i16((__attribute__((address_space(3))) v4i16_t*)p)); }
__device__ __forceinline__ float rowmax(const f32x16&p0,const f32x16&p1){
  float a=max3f(p0[0],p0[1],p1[0]),b=max3f(p0[2],p0[3],p1[1]);a=max3f(a,p1[2],p1[3]);
  #pragma unroll
  for(int r=4;r<16;r+=4){a=max3f(a,p0[r],p0[r+1]);b=max3f(b,p0[r+2],p0[r+3]);a=max3f(a,p1[r],p1[r+1]);b=max3f(b,p1[r+2],p1[r+3]);}
  const float m=max2f(a,b);
  auto rr=__builtin_amdgcn_permlane32_swap(__float_as_uint(m),__float_as_uint(m),false,false);
  return max2f(__uint_as_float(rr[0]),__uint_as_float(rr[1]));
}
__device__ __forceinline__ void pv(f32x16*o,int vb,bf16x8 pa0,bf16x8 pa1,bf16x8 pa2,bf16x8 pa3){
  #pragma unroll
  for(int d0=0;d0<2;++d0){s16x4 lo[4],hi[4];
    #pragma unroll
    for(int ks=0;ks<4;++ks){
      asm volatile("ds_read_b64_tr_b16 %0,%1 offset:%c2":"=&v"(lo[ks]):"v"(vb),"i"(d0*4096+ks*1024):"memory");
      asm volatile("ds_read_b64_tr_b16 %0,%1 offset:%c2":"=&v"(hi[ks]):"v"(vb),"i"(d0*4096+ks*1024+512):"memory");}
    asm volatile("s_waitcnt lgkmcnt(0)":::"memory");SBAR();
    #define PK(k) (bf16x8){lo[k][0],lo[k][1],lo[k][2],lo[k][3],hi[k][0],hi[k][1],hi[k][2],hi[k][3]}
    o[d0]=__builtin_amdgcn_mfma_f32_32x32x16_bf16(pa0,PK(0),o[d0],0,0,0);
    o[d0]=__builtin_amdgcn_mfma_f32_32x32x16_bf16(pa1,PK(1),o[d0],0,0,0);
    o[d0]=__builtin_amdgcn_mfma_f32_32x32x16_bf16(pa2,PK(2),o[d0],0,0,0);
    o[d0]=__builtin_amdgcn_mfma_f32_32x32x16_bf16(pa3,PK(3),o[d0],0,0,0);
    #undef PK
  }
}

#ifndef ATTN_STORE16
#define ATTN_STORE16(p,v) (*(u32x4*)(p)=(v))
#endif
__device__ __forceinline__ void attn_preload(int b,int h,int qb,const bf16*Q,const float*kms,bf16x8(&qr)[4],f32x2_t&kmv,int wave_){
  int tzp=my_tid(wave_); asm volatile("":"+v"(tzp)); const int ln=tzp&63,r32=ln&31,hi=ln>>5;
  const bf16*Qw=Q+((long)b*SEQ+qb*QB+wave_*QBLK)*DM+h*D;
  #pragma unroll
  for(int d0=0;d0<4;++d0)qr[d0]=*reinterpret_cast<const bf16x8*>(&Qw[(long)r32*DM+d0*16+hi*8]);
  kmv=*(const f32x2_t*)(kms+tzp*2);
}
__device__ __forceinline__ void attn_unit(int b,int h,int qb,const bf16*Q,const bf16*__restrict__ K,const bf16*__restrict__ V,bf16*O,char*shm,int wave_,bf16x8(&qr)[4],f32x2_t&kmv,int nb,int nh,int nqb,const float*nkms){
  int tid=my_tid(wave_); asm volatile("":"+v"(tid));
  const int lane=tid&63,r32=lane&31,hi=lane>>5; const int wid=wave_;
  const long rowbase=(long)b*SEQ; const int q0=qb*QB;
  const bf16*Qw=Q+(rowbase+q0+wid*QBLK)*DM+h*D;
  const bf16*Kh=K+rowbase*DM+h*D,*Vh=V+rowbase*DM+h*D;
  const unsigned lds0=(unsigned)(uintptr_t)shm;
  float*wsf=(float*)(shm+LDS_WS)+wid*64;
  const bf16*ksrc=Kh+(long)lane*DM+wid*8;
  const bf16*vsrc=Vh+(long)(16*(wid&3)+(lane>>2))*DM+(wid>>2)*32+(lane&3)*8;
  const unsigned kdst=lds0+LDS_K+wid*1024, vdst=lds0+LDS_V+wid*1024;
  #define DMA_K(t,slot) glds16(ksrc+(long)(t)*KVBLK*DM,(unsigned)__builtin_amdgcn_readfirstlane(kdst+(slot)))
  #define DMA_V(t,slot) glds16(vsrc+(long)(t)*KVBLK*DM,(unsigned)__builtin_amdgcn_readfirstlane(vdst+(slot)))
  const char*Kbase=shm+LDS_K; bf16x8 kf[8];
  const lds_cptr shm3=(lds_cptr)shm; const lds_cptr kp0=shm3+LDS_K+hi*1024+r32*16; const lds_cptr vp0=shm3+LDS_V+((lane>>4)&1)*32+(lane&3)*8+(4*hi+((lane&15)>>2))*64;
  const int NT=(q0+QB)/KVBLK;
  float l_reg=0.f;f32x16 o[2];f32x16 cin;
  const int qrel=wid*QBLK+r32;
  { const int t8=tid; *(f32x2_t*)(shm+LDS_KMS+t8*8)=kmv; }
  asm volatile("" : "+v"(qr[0]),"+v"(qr[1]),"+v"(qr[2]),"+v"(qr[3]));
  int selmask=1<<qb;
  DMA_K(0,0);DMA_V(0,0);DMA_K(1,SLOTB);DMA_K(2,2*SLOTB);
  asm volatile("s_waitcnt lgkmcnt(0)\n\ts_barrier":::"memory");
  { float v1=-INFINITY,v2=-INFINITY,v3=-INFINITY; int i1=-1,i2=-1,i3=-1; float qf[4][8];
    _Pragma("unroll") for(int d0=0;d0<4;++d0) _Pragma("unroll") for(int j=0;j<8;++j) qf[d0][j]=__builtin_bit_cast(float,((unsigned)(unsigned short)qr[d0][j])<<16);
    for(int n=0;n<qb;++n){ const f32x4_t*kp=(const f32x4_t*)(shm+LDS_KMS+(n*64+8*hi)*4); float g=0.f;
      _Pragma("unroll") for(int d0=0;d0<4;++d0){ const f32x4_t a=kp[4*d0],c=kp[4*d0+1]; g+=qf[d0][0]*a[0]+qf[d0][1]*a[1]+qf[d0][2]*a[2]+qf[d0][3]*a[3]+qf[d0][4]*c[0]+qf[d0][5]*c[1]+qf[d0][6]*c[2]+qf[d0][7]*c[3]; }
      { auto rr=__builtin_amdgcn_permlane32_swap(__float_as_uint(g),__float_as_uint(g),false,false); g=__uint_as_float(rr[0])+__uint_as_float(rr[1]); }
      const bool a1=g>v1,a2=g>v2,a3=g>v3;
      v3=a2?v2:(a3?g:v3); i3=a2?i2:(a3?n:i3);
      v2=a1?v1:(a2?g:v2); i2=a1?i1:(a2?n:i2);
      v1=a1?g:v1;         i1=a1?n:i1; }
    if(i1>=0)selmask|=1<<i1; if(i2>=0)selmask|=1<<i2; if(i3>=0)selmask|=1<<i3; }
  WAIT_BAR(3);
  const float c2=__builtin_amdgcn_exp2f(-0.5f*(float)(h+1))*1.4426950408889634f; const int qk=q0+qrel-4*hi;
  const float k32=__builtin_amdgcn_exp2f(32.f*c2);
  #define CINIT(t_) do{ const int tt_=(t_); const float base_=((selmask>>(tt_>>2))&1)?__builtin_fmaf(-c2,(float)(qk-64*tt_),-MFIX):-1e30f; \
    _Pragma("unroll") for(int r=0;r<16;++r)cin[r]=__builtin_fmaf(c2,(float)((r&3)+8*(r>>2)),base_); asm volatile("":"+v"(cin)); }while(0)
  #define CNEXT(t_) do{ const int tn_=(t_); if((tn_&3)==0){ CINIT(tn_); } else { const float st_=64.f*c2; _Pragma("unroll") for(int r=0;r<16;++r)cin[r]+=st_; asm volatile("":"+v"(cin)); } }while(0)
  CINIT(0); o[0]=f32x16{};o[1]=f32x16{};
  #define CMASK(P0,P1,t) do{int jb_=(t)-(NT-4); if(jb_>=0)cmask(P0,P1,jb_,qrel,hi);}while(0)
  #define START(P0,P1) do{ CINIT(1); _Pragma("unroll") for(int r=0;r<16;++r)P0[r]=__builtin_amdgcn_exp2f(P0[r]); }while(0)
  #define RESC() do{}while(0)
  f32x16 pA0,pA1,pB0,pB1;
  int sl_prev=0,sl_cur=0,sl_next=SLOTB;
  #define ROT() do{sl_prev=sl_cur;sl_cur=sl_next;sl_next=(sl_next==(NSLOT-1)*SLOTB)?0:sl_next+SLOTB;}while(0)
  qkt(pA0,pA1,Kbase,qr,cin,r32,hi);asm volatile("s_nop 15\n\ts_nop 7":"+v"(pA0),"+v"(pA1));CMASK(pA0,pA1,0);
  START(pA0,pA1);
  _Pragma("unroll") for(int r=0;r<16;++r)pA1[r]=__builtin_amdgcn_exp2f(pA1[r]);
  WAIT_BAR(0);
  DMA_K(3,0);DMA_V(1,SLOTB);
  ROT();
  kload8(kf,kp0+sl_cur);
  WAIT_BAR(2);
  s16x4 vlo[8],vhi[8]; u32x4 pw0,pw1,pw2,pw3;
  #define PKW(P,B) cvtpk_s(P[B],P[B+1])
  #define PAF(k) __builtin_bit_cast(bf16x8,pw##k)
  #define VFR(i) (bf16x8){vlo[i][0],vlo[i][1],vlo[i][2],vlo[i][3],vhi[i][0],vhi[i][1],vhi[i][2],vhi[i][3]}
  #define PIN(x) asm volatile("":"+v"(x))
  #define MX3(a,b,c) __builtin_fmaxf(__builtin_fmaxf((a),(b)),(c))
  #define GAPA(MF,A0,A1,A2,A3,W0,W1,PW) do{ MF; sacc+=A0; sacc+=A1; sacc+=A2; sacc+=A3; PIN(sacc); W0; W1; PIN(PW); SBAR(); }while(0)
  #define GAPA2(MF,A0,A1,B0,B1,W0,W1,PW) do{ MF; sacc+=A0; sacc+=A1; sacc1=B0+B1; PIN(sacc); PIN(sacc1); W0; W1; PIN(PW); SBAR(); }while(0)
  #define GAPA1(MF,A0,A1,A2,A3,W0,W1,PW) do{ MF; sacc1+=A0; sacc1+=A1; sacc1+=A2; sacc1+=A3; PIN(sacc1); W0; W1; PIN(PW); SBAR(); }while(0)
  #define EX(v) __builtin_amdgcn_exp2f(v)
  #define GAPB(MF,X,B) do{ MF; X[B]=EX(X[B]); X[B+1]=EX(X[B+1]); X[B+2]=EX(X[B+2]); X[B+3]=EX(X[B+3]); PIN(X); SBAR(); }while(0)
  #define GAPBC(MF,X,B) GAPB(MF,X,B)
  #define VRD(i) do{ vlo[i]=vtr(vp_+(((i)>>2)*4096+((i)&3)*1024)); vhi[i]=vtr(vp_+(((i)>>2)*4096+((i)&3)*1024+512)); }while(0)
  #define KRD(G,j) do{ if(G){ kload2(kf,kp0+sl_next,j); SBAR(); } }while(0)
  #define STEP(C0,C1,P0,P1,t,GK,GV,GL) do{ SBAR(); \
    const lds_cptr vp_=vp0+sl_prev; \
    VRD(0); SBAR(); float sacc=(P0[0]+P0[1]),sacc1; \
    GAPA(C0=__builtin_amdgcn_mfma_f32_32x32x16_bf16(kf[0],qr[0],cin,0,0,0), P0[2],P0[3],P0[4],P0[5],     pw0[0]=PKW(P0,0), pw0[1]=PKW(P0,2), pw0); \
    VRD(4); SBAR(); GAPA(C1=__builtin_amdgcn_mfma_f32_32x32x16_bf16(kf[1],qr[0],cin,0,0,0), P0[6],P0[7],P0[8],P0[9],     pw0[2]=PKW(P0,4), pw0[3]=PKW(P0,6), pw0); \
    VRD(1); SBAR(); GAPA(C0=__builtin_amdgcn_mfma_f32_32x32x16_bf16(kf[2],qr[1],C0,0,0,0),   P0[10],P0[11],P0[12],P0[13], pw1[0]=PKW(P0,8), pw1[1]=PKW(P0,10), pw1); \
    VRD(5); SBAR(); GAPA2(C1=__builtin_amdgcn_mfma_f32_32x32x16_bf16(kf[3],qr[1],C1,0,0,0),  P0[14],P0[15],P1[0],P1[1],   pw1[2]=PKW(P0,12),pw1[3]=PKW(P0,14), pw1); \
    VRD(2); SBAR(); GAPA1(C0=__builtin_amdgcn_mfma_f32_32x32x16_bf16(kf[4],qr[2],C0,0,0,0),  P1[2],P1[3],P1[4],P1[5],     pw2[0]=PKW(P1,0), pw2[1]=PKW(P1,2), pw2); \
    VRD(6); SBAR(); GAPA1(C1=__builtin_amdgcn_mfma_f32_32x32x16_bf16(kf[5],qr[2],C1,0,0,0),  P1[6],P1[7],P1[8],P1[9],     pw2[2]=PKW(P1,4), pw2[3]=PKW(P1,6), pw2); \
    VRD(3); SBAR(); GAPA1(C0=__builtin_amdgcn_mfma_f32_32x32x16_bf16(kf[6],qr[3],C0,0,0,0),  P1[10],P1[11],P1[12],P1[13], pw3[0]=PKW(P1,8), pw3[1]=PKW(P1,10), pw3); \
    VRD(7); SBAR(); GAPA1(C1=__builtin_amdgcn_mfma_f32_32x32x16_bf16(kf[7],qr[3],C1,0,0,0),  P1[14],P1[15],0.f,0.f,       pw3[2]=PKW(P1,12),pw3[3]=PKW(P1,14), pw3); \
    l_reg+=sacc; l_reg=__builtin_fmaf(k32,sacc1,l_reg); \
    if(GK){DMA_K((t)+3,sl_cur);} if(GV){DMA_V((t)+1,sl_next);} \
    CMASK(C0,C1,t); \
    CNEXT((t)+1); \
    SBAR(); \
    GAPB(o[0]=__builtin_amdgcn_mfma_f32_32x32x16_bf16(PAF(0),VFR(0),o[0],0,0,0), C0,0); \
    GAPB(o[1]=__builtin_amdgcn_mfma_f32_32x32x16_bf16(PAF(0),VFR(4),o[1],0,0,0), C0,4); \
    KRD(GL,0); GAPB(o[0]=__builtin_amdgcn_mfma_f32_32x32x16_bf16(PAF(1),VFR(1),o[0],0,0,0), C0,8); \
    KRD(GL,1); GAPB(o[1]=__builtin_amdgcn_mfma_f32_32x32x16_bf16(PAF(1),VFR(5),o[1],0,0,0), C0,12); \
    KRD(GL,2); GAPBC(o[0]=__builtin_amdgcn_mfma_f32_32x32x16_bf16(PAF(2),VFR(2),o[0],0,0,0), C1,0); \
    KRD(GL,3); GAPBC(o[1]=__builtin_amdgcn_mfma_f32_32x32x16_bf16(PAF(2),VFR(6),o[1],0,0,0), C1,4); \
    GAPBC(o[0]=__builtin_amdgcn_mfma_f32_32x32x16_bf16(PAF(3),VFR(3),o[0],0,0,0), C1,8); \
    GAPBC(o[1]=__builtin_amdgcn_mfma_f32_32x32x16_bf16(PAF(3),VFR(7),o[1],0,0,0), C1,12); \
    }while(0)
  int t=1;
  #undef CMASK
  #define CMASK(P0,P1,t) do{}while(0)
  for(;t+5<NT;t+=2){
    STEP(pB0,pB1,pA0,pA1,t,true,true,true);     WAIT_BAR(2); RESC(); ROT();
    STEP(pA0,pA1,pB0,pB1,t+1,true,true,true);   WAIT_BAR(2); RESC(); ROT();
  }
  #undef CMASK
  int tzb=my_tid(wave_); asm volatile("":"+v"(tzb)); const int hib=(tzb>>5)&1, qrelb=(tzb>>6)*QBLK+(tzb&31);
  #define CMASK(P0,P1,t) do{int jb_=(t)-(NT-4); if(jb_>=0)cmask(P0,P1,jb_,qrelb,hib);}while(0)
  #define ENDW(tt) do{ if((tt)+3<NT){WAIT_BAR(2);} else if((tt)+2<NT){WAIT_BAR(1);} else {WAIT_BAR(0);} }while(0)
  for(;t+1<NT;t+=2){
    STEP(pB0,pB1,pA0,pA1,t,(t+3<NT),(t+1<NT),(t+1<NT));       ENDW(t);   RESC(); ROT();
    STEP(pA0,pA1,pB0,pB1,t+1,(t+4<NT),(t+2<NT),(t+2<NT));     ENDW(t+1); RESC(); ROT();
  }
  STEP(pB0,pB1,pA0,pA1,NT-1,false,false,false); RESC();
  attn_preload(nb,nh,nqb,Q,nkms,qr,kmv,wave_);
  { float sacc=pB0[0]+pB0[1],sacc1=pB1[0]+pB1[1]; _Pragma("unroll") for(int r=2;r<16;++r)sacc+=pB0[r]; _Pragma("unroll") for(int r=2;r<16;++r)sacc1+=pB1[r]; l_reg+=sacc; l_reg=__builtin_fmaf(k32,sacc1,l_reg);
    pw0=(u32x4){PKW(pB0,0),PKW(pB0,2),PKW(pB0,4),PKW(pB0,6)};pw1=(u32x4){PKW(pB0,8),PKW(pB0,10),PKW(pB0,12),PKW(pB0,14)};pw2=(u32x4){PKW(pB1,0),PKW(pB1,2),PKW(pB1,4),PKW(pB1,6)};pw3=(u32x4){PKW(pB1,8),PKW(pB1,10),PKW(pB1,12),PKW(pB1,14)};
    int tzd=my_tid(wave_); asm volatile("":"+v"(tzd)); const int ld_=tzd&63; const int vb0=(int)(lds0+LDS_V)+((ld_>>4)&1)*32+(ld_&3)*8+(4*(ld_>>5)+((ld_&15)>>2))*64;
    SBAR(); pv(o,vb0+sl_cur,PAF(0),PAF(1),PAF(2),PAF(3)); }
  #undef PKW
  #undef PAF
  #undef VFR
  #undef PIN
  #undef MX3
  #undef GAPA
  #undef GAPB
  #undef GAPBC
  #undef EX
  #undef VRD
  #undef KRD
  #undef STEP
  #undef ENDW
  int tze=my_tid(wave_); asm volatile("":"+v"(tze));
  { const int lane=tze&63,r32=lane&31,hi=lane>>5; const int wid=wave_; float*wsf=(float*)(shm+LDS_WS)+wid*64;
  {auto rr=__builtin_amdgcn_permlane32_swap(__float_as_uint(l_reg),__float_as_uint(l_reg),false,false);l_reg=__uint_as_float(rr[0])+__uint_as_float(rr[1]);}
  if(hi==0)wsf[32+r32]=l_reg;asm volatile("s_waitcnt lgkmcnt(0)":::"memory");
  float rli[16];
  #pragma unroll
  for(int r=0;r<16;++r)rli[r]=__builtin_amdgcn_rcpf(wsf[32+crow(r,hi)]);
  bf16*Ow=O+(rowbase+q0+wid*QBLK)*DM+h*D;
  { bf16*stg=(bf16*)(shm+LDS_OST)+wid*2048;
    #pragma unroll
    for(int r=0;r<16;++r){const int orow=crow(r,hi);
      #pragma unroll
      for(int d0=0;d0<2;++d0)stg[orow*64+d0*32+r32]=(bf16)::f2bf(o[d0][r]*rli[r]);}
    asm volatile("s_waitcnt lgkmcnt(0)":::"memory");
    #pragma unroll
    for(int i=0;i<4;++i){const int row=i*8+(lane>>3),ch=lane&7; const u32x4 v=*(const u32x4*)(stg+row*64+ch*8); ATTN_STORE16(Ow+(long)row*DM+ch*8,v);} }
  }
  asm volatile("s_waitcnt lgkmcnt(0)\n\ts_barrier":::"memory");
  #undef DMA_K
  #undef DMA_V
  #undef CMASK
  #undef START
  #undef RESC
  #undef CINIT
  #undef ROT
}
constexpr int ATTN_LDS_BYTES=LDS_BYTES;
struct AttnTensors { const bf16* Q; const bf16* K; const bf16* V; bf16* O; };
struct AttnUnit { int bh; int qb; };
struct StaticOrder {
  int vcu;
  __device__ __forceinline__ explicit StaticOrder(int grid,int block):vcu((block%8)*(grid/8)+block/8){}
  __device__ __forceinline__ bool next(int i,AttnUnit&u)const{ if(i>=8)return false; const int x=vcu>>5,c=vcu&31,g=i>>1,k=c&7; u.bh=x*16+g*4+(c>>3); u.qb=(i&1)?k:15-k; return true; }
};
__device__ __forceinline__ void attn_phase(char*lds,const AttnTensors&T,const float*kmean,const StaticOrder&S,int wave_){
  AttnUnit u;
  bf16x8 qr[4]; f32x2_t kmv; AttnUnit un; if(!S.next(0,u))return; attn_preload(u.bh/NHEAD,u.bh%NHEAD,u.qb,T.Q,kmean+(size_t)u.bh*16*64,qr,kmv,wave_);
  for(int i=0;;++i){ const bool hn=S.next(i+1,un); if(!hn)un=u; attn_unit(u.bh/NHEAD,u.bh%NHEAD,u.qb,T.Q,T.K,T.V,T.O,lds,wave_,qr,kmv,un.bh/NHEAD,un.bh%NHEAD,un.qb,kmean+(size_t)un.bh*16*64); if(!hn)break; u=un; }
}
#undef SBAR
#undef WAIT_BAR
}

struct Frame {
    LAS unsigned char* lds; int tid, lane, wave, vcu, G;
};
__device__ __forceinline__ Frame phase_frame(const Frame& F0) { Frame F = F0; F.tid = my_tid(F0.wave); asm volatile("" : "+v"(F.tid)); F.lane = F.tid & 63; return F; }
#define LDS_WAIT() asm volatile("s_waitcnt lgkmcnt(0)" ::: "memory")

struct CvtItem { const float* src; unsigned char* dst; int N, KB, f8; };
__device__ __forceinline__ void cvt_load(const CvtItem& it, f32x4 (&v)[8], int lane) {
#pragma unroll
    for (int i = 0; i < 8; ++i) v[i] = __builtin_nontemporal_load((const f32x4*)(it.src + (size_t)(8 * i + (lane >> 3)) * it.N + (lane & 7) * 4));
}
__device__ __forceinline__ void cvt_store(const CvtItem& it, const f32x4 (&v)[8], LAS float* scr, int lane) {
#pragma unroll
    for (int i = 0; i < 8; ++i) { LAS float* d = scr + (8 * i + (lane >> 3)) * 33 + (lane & 7) * 4; d[0] = v[i].x; d[1] = v[i].y; d[2] = v[i].z; d[3] = v[i].w; }
    LDS_WAIT(); asm volatile("" ::: "memory");
    const int c = lane & 7;
#pragma unroll
    for (int j = 0; j < 4; ++j) { const int n = (lane >> 3) + 8 * j; const LAS float* s = scr + (8 * c) * 33 + n;
        if (it.f8) { u32x2 o; o.x = pk4_fp8(s[0 * 33] * F8_SW, s[1 * 33] * F8_SW, s[2 * 33] * F8_SW, s[3 * 33] * F8_SW); o.y = pk4_fp8(s[4 * 33] * F8_SW, s[5 * 33] * F8_SW, s[6 * 33] * F8_SW, s[7 * 33] * F8_SW);
            *(u32x2*)(it.dst + (size_t)n * it.KB + 8 * c) = o; }
        else { u32x4 o; o.x = pk2(s[0 * 33], s[1 * 33]); o.y = pk2(s[2 * 33], s[3 * 33]); o.z = pk2(s[4 * 33], s[5 * 33]); o.w = pk2(s[6 * 33], s[7 * 33]);
            *(u32x4*)(it.dst + (size_t)n * it.KB + 16 * c) = o; } }
    LDS_WAIT(); asm volatile("" ::: "memory");
}
__device__ __forceinline__ CvtItem cvt_plain(const float* W, int K, int N, unsigned char* WT, int item, bool f8) {
    const int nblk = N / 32, kb = item / nblk, nb = item % nblk, es = f8 ? 1 : 2; CvtItem it; it.src = W + (size_t)(64 * kb) * N + 32 * nb; it.N = N; it.KB = K * es; it.f8 = f8; it.dst = WT + (size_t)(32 * nb) * it.KB + 64 * kb * es; return it;
}
__device__ __forceinline__ CvtItem cvt_moe(const float* wg, const float* wu, const float* wd, unsigned char* W1, unsigned char* W2, int item) {
    const int e = item / 1536, r = item % 1536, kind = r / 512, t = r % 512, kb = t / 32, nb = t % 32, n0 = 32 * nb; const size_t wo = (size_t)e * DM * DM;
    constexpr int ES1 = MOE1_FP8 ? 1 : 2, ES2 = MOE2_FP8 ? 1 : 2; CvtItem it; it.N = DM;
    if (kind == 2) { it.src = wd + wo + (size_t)(64 * kb) * DM + n0; it.KB = DM * ES2; it.f8 = MOE2_FP8; it.dst = W2 + ((size_t)e * DM + n0) * it.KB + 64 * kb * ES2; }
    else { it.src = (kind ? wu : wg) + wo + (size_t)(64 * kb) * DM + n0; it.KB = DM * ES1; it.f8 = MOE1_FP8; it.dst = W1 + ((size_t)e * 2048 + (n0 >> 7) * 256 + kind * 128 + (n0 & 127)) * it.KB + 64 * kb * ES1; }
    return it;
}
struct ModP { const float* g; const float* shift; const float* scale; bf16* out; };
template <int NOUT> __device__ __forceinline__ void norm_mod_regs(const f32x4 (&v)[4], int b, int lane, const ModP& p0, int bs0, const ModP& p1, int bs1) {
    float ss = 0.f;
#pragma unroll
    for (int j = 0; j < 4; ++j) ss += v[j].x * v[j].x + v[j].y * v[j].y + v[j].z * v[j].z + v[j].w * v[j].w;
    const float rstd = rsqrtf(wave_sum(ss) * (1.0f / DM) + EPS);
#pragma unroll
    for (int o = 0; o < NOUT; ++o) { const ModP& p = o ? p1 : p0; const int bs = o ? bs1 : bs0;
#pragma unroll
        for (int j = 0; j < 4; ++j) { const int c4 = lane + 64 * j; const f32x4 g = ((const f32x4*)p.g)[c4], sh = ((const f32x4*)(p.shift + (size_t)b * bs))[c4], sc = ((const f32x4*)(p.scale + (size_t)b * bs))[c4];
            const f32x4 h = v[j] * rstd * g * (sc + 1.0f) + sh;
            u32x2 w; w.x = pk2(h.x, h.y); w.y = pk2(h.z, h.w); ((u32x2*)p.out)[c4] = w; } }
}

struct Args { const float* in[28]; float* out; unsigned char* ws; int ph_lo, ph_hi; };
__device__ __forceinline__ void cvt_moe_share(const Frame& F0, const Args& args, int layer) {
    const Frame F = phase_frame(F0);
    const int gw = F.vcu * NWAVES + F.wave, NGW = F.G * NWAVES;
    LAS float* scr = (LAS float*)(F.lds + F.wave * 8448);
    const size_t wo = (size_t)layer * NE * DM * DM; unsigned char* ws = args.ws;
    constexpr int NIT = 32 * 1536;
    auto decode = [&](int it) -> CvtItem { return cvt_moe(args.in[22] + wo, args.in[24] + wo, args.in[26] + wo, ws + WS_W1, ws + WS_W2, it); };
    const int n = gw < NIT ? (NIT - gw + NGW - 1) / NGW : 0, n4 = n & ~3;
    if (n4 > 0) { CvtItem c0 = decode(gw), c1 = decode(gw + NGW), c2 = decode(gw + 2 * NGW), c3 = decode(gw + 3 * NGW); f32x4 v0[8], v1[8], v2[8], v3[8];
        cvt_load(c0, v0, F.lane); cvt_load(c1, v1, F.lane); cvt_load(c2, v2, F.lane); cvt_load(c3, v3, F.lane);
#pragma unroll 1
        for (int q = 4; q < n4; q += 4) { const int it = gw + q * NGW;
            cvt_store(c0, v0, scr, F.lane); c0 = decode(it); cvt_load(c0, v0, F.lane); __builtin_amdgcn_sched_barrier(0);
            cvt_store(c1, v1, scr, F.lane); c1 = decode(it + NGW); cvt_load(c1, v1, F.lane); __builtin_amdgcn_sched_barrier(0);
            cvt_store(c2, v2, scr, F.lane); c2 = decode(it + 2 * NGW); cvt_load(c2, v2, F.lane); __builtin_amdgcn_sched_barrier(0);
            cvt_store(c3, v3, scr, F.lane); c3 = decode(it + 3 * NGW); cvt_load(c3, v3, F.lane); __builtin_amdgcn_sched_barrier(0); }
        cvt_store(c0, v0, scr, F.lane); __builtin_amdgcn_sched_barrier(0); cvt_store(c1, v1, scr, F.lane); __builtin_amdgcn_sched_barrier(0); cvt_store(c2, v2, scr, F.lane); __builtin_amdgcn_sched_barrier(0); cvt_store(c3, v3, scr, F.lane); }
    for (int q = n4; q < n; ++q) { const CvtItem c = decode(gw + q * NGW); f32x4 v[8]; cvt_load(c, v, F.lane); cvt_store(c, v, scr, F.lane); }
}
#ifndef ONLY_PHASE
#define ONLY_PHASE -1
#endif
#ifndef PH_MASK
#define PH_MASK 0xffff
#endif
#define CK(k) ((ONLY_PHASE < 0 || ONLY_PHASE == (k)) && ((PH_MASK >> (k)) & 1))
#ifndef DUP_PHASE
#define DUP_PHASE -1
#endif
#define DUP(k) _Pragma("unroll") for (int rep_ = 0; rep_ < (DUP_PHASE == (k) ? 2 : 1); ++rep_)

typedef float f32x16 __attribute__((ext_vector_type(16)));
__device__ __forceinline__ void top4_insert(float v, int i, float (&tv)[4], int (&ti)[4]) {
    const bool a0 = v > tv[0] || (v == tv[0] && i < ti[0]), a1 = v > tv[1] || (v == tv[1] && i < ti[1]), a2 = v > tv[2] || (v == tv[2] && i < ti[2]), a3 = v > tv[3] || (v == tv[3] && i < ti[3]);
    tv[3] = a2 ? tv[2] : (a3 ? v : tv[3]); ti[3] = a2 ? ti[2] : (a3 ? i : ti[3]);
    tv[2] = a1 ? tv[1] : (a2 ? v : tv[2]); ti[2] = a1 ? ti[1] : (a2 ? i : ti[2]);
    tv[1] = a0 ? tv[0] : (a1 ? v : tv[1]); ti[1] = a0 ? ti[0] : (a1 ? i : ti[1]);
    tv[0] = a0 ? v : tv[0];               ti[0] = a0 ? i : ti[0];
}
template <int L> __device__ __forceinline__ void ph_router(const Frame& F0, const Args& args) {
    const Frame F = phase_frame(F0);
    unsigned char* ws = args.ws; const float* ml = (const float*)(ws + WS_MOD) + (size_t)L * NB * 6144; int* cl = (int*)(ws + WS_CTL) + CW_CNT + L * 64;
    int* rowt = (int*)(ws + WS_ROWT); float* rowp = (float*)(ws + WS_ROWP); bf16* HA = (bf16*)(ws + WS_HA); const bf16* xs = (const bf16*)(ws + WS_XS);
    const int lane = F.lane; const int gw = F.vcu * NWAVES + F.wave, NGW = F.G * NWAVES;
    {
        const int T = F.vcu * 4 + (F.wave & 3), kq = F.wave >> 2;
        LAS float* xch = (LAS float*)(F.lds + (F.wave & 3) * 64 * 17 * 4);
        if (F.tid < 8) ((LAS int*)(F.lds + 17920))[256 + F.tid] = 0;
        LAS float* rsx = (LAS float*)(F.lds + 4 * 64 * 17 * 4) + (F.wave & 3) * 32;
        const float* g = args.in[5] + L * DM;
        for (int tile = T; tile < NTOK / 32; tile += F.G * 4) {
            const int tok0 = tile * 32, b = tok0 / SEQ, j = lane & 31, kh = lane >> 5;
            const bf16* xr = xs + (size_t)(tok0 + j) * DM + 8 * kh + 512 * kq;
            const u32x4* wp = (const u32x4*)(ws + WS_RW3) + ((size_t)(L * NB + b) * 2 + kq) * (32 * 3 * 64) + lane;
            f32x16 acc; float ss = 0.f;
#pragma unroll
            for (int r = 0; r < 16; ++r) acc[r] = 0.f;
#define RT_LD(S_, A_, X_) { A_[0] = wp[((S_) * 3) * 64]; A_[1] = wp[((S_) * 3 + 1) * 64]; A_[2] = wp[((S_) * 3 + 2) * 64]; X_ = *(const u32x4*)(xr + 16 * (S_)); }
#define RT_MM(A_, X_) { const u32x4 xw = X_; \
                const f32x4 b0 = (f32x4){bf2f(xw.x & 0xffffu), bf2f(xw.x >> 16), bf2f(xw.y & 0xffffu), bf2f(xw.y >> 16)}, b1 = (f32x4){bf2f(xw.z & 0xffffu), bf2f(xw.z >> 16), bf2f(xw.w & 0xffffu), bf2f(xw.w >> 16)}; \
                ss += (b0[0] * b0[0] + b0[1] * b0[1]) + (b0[2] * b0[2] + b0[3] * b0[3]) + (b1[0] * b1[0] + b1[1] * b1[1]) + (b1[2] * b1[2] + b1[3] * b1[3]); \
                const bf16x8 xb = __builtin_bit_cast(bf16x8, xw); \
                acc = __builtin_amdgcn_mfma_f32_32x32x16_bf16(__builtin_bit_cast(bf16x8, A_[2]), xb, acc, 0, 0, 0); \
                acc = __builtin_amdgcn_mfma_f32_32x32x16_bf16(__builtin_bit_cast(bf16x8, A_[1]), xb, acc, 0, 0, 0); \
                acc = __builtin_amdgcn_mfma_f32_32x32x16_bf16(__builtin_bit_cast(bf16x8, A_[0]), xb, acc, 0, 0, 0); }
            u32x4 qa[3], ra[3], qx, rx;
            RT_LD(0, qa, qx); RT_LD(1, ra, rx);
#pragma unroll 4
            for (int s = 0; s < 32; s += 2) {
                const int s2 = s + 2 < 32 ? s + 2 : 31, s3 = s + 3 < 32 ? s + 3 : 31;
                { u32x4 ta[3] = {qa[0], qa[1], qa[2]}; const u32x4 tx = qx; RT_LD(s2, qa, qx); __builtin_amdgcn_sched_barrier(0); RT_MM(ta, tx); __builtin_amdgcn_sched_barrier(0); }
                { u32x4 ta[3] = {ra[0], ra[1], ra[2]}; const u32x4 tx = rx; RT_LD(s3, ra, rx); __builtin_amdgcn_sched_barrier(0); RT_MM(ta, tx); __builtin_amdgcn_sched_barrier(0); }
            }
            __syncthreads();
            if (kq == 1) {
#pragma unroll
                for (int r = 0; r < 16; ++r) xch[lane * 17 + r] = acc[r];
                xch[lane * 17 + 16] = ss; }
            __syncthreads();
            float rstd = 0.f;
            if (kq == 0) {
#pragma unroll
                for (int r = 0; r < 16; ++r) acc[r] += xch[lane * 17 + r];
                ss += xch[lane * 17 + 16];
                ss += __shfl_xor(ss, 32);
                rstd = rsqrtf(ss * (1.0f / DM) + EPS);
                if constexpr (MOE1_FP8 != 0) { if (kh == 0) rsx[j] = rstd; } }
            if constexpr (MOE1_FP8 != 0) {
                __syncthreads();
                if (kq == 1) {
                    f32x4 am[4], sm[4];
#pragma unroll
                    for (int jj = 0; jj < 4; ++jj) { const int c4 = lane + 64 * jj; am[jj] = ((const f32x4*)g)[c4] * (((const f32x4*)(ml + 4096 + (size_t)b * 6144))[c4] + 1.0f) * F8_SH; sm[jj] = ((const f32x4*)(ml + 3072 + (size_t)b * 6144))[c4] * F8_SH; }
                    u32x2 vn[4];
#pragma unroll
                    for (int jj = 0; jj < 4; ++jj) vn[jj] = ((const u32x2*)(xs + (size_t)tok0 * DM))[lane + 64 * jj];
#pragma unroll 2
                    for (int r = 0; r < 32; ++r) { u32x2 vc[4];
#pragma unroll
                        for (int jj = 0; jj < 4; ++jj) vc[jj] = vn[jj];
                        const int rn = r + 1 < 32 ? r + 1 : r;
#pragma unroll
                        for (int jj = 0; jj < 4; ++jj) vn[jj] = ((const u32x2*)(xs + (size_t)(tok0 + rn) * DM))[lane + 64 * jj];
                        const float rs = rsx[r];
#pragma unroll
                        for (int jj = 0; jj < 4; ++jj) { const f32x4 v = (f32x4){bf2f(vc[jj].x & 0xffffu), bf2f(vc[jj].x >> 16), bf2f(vc[jj].y & 0xffffu), bf2f(vc[jj].y >> 16)};
                            const f32x4 h = v * rs * am[jj] + sm[jj]; ((unsigned*)((unsigned char*)HA + (size_t)(tok0 + r) * DM))[lane + 64 * jj] = pk4_fp8(h.x, h.y, h.z, h.w); } }
                    continue; }
            } else { if (kq == 1) continue; }
            const float* cb = (const float*)(ws + WS_RCB) + (size_t)(L * NB + b) * NE;
            float tv[4] = {-INFINITY, -INFINITY, -INFINITY, -INFINITY}; int ti[4] = {64, 65, 66, 67};
#pragma unroll
            for (int r = 0; r < 16; ++r) { const int e = (r & 3) + 8 * (r >> 2) + 4 * kh; top4_insert(acc[r] * rstd + cb[e], e, tv, ti); }
            float pv[4]; int pi[4];
#pragma unroll
            for (int k = 0; k < 4; ++k) { pv[k] = __shfl_xor(tv[k], 32); pi[k] = __shfl_xor(ti[k], 32); }
#pragma unroll
            for (int k = 0; k < 4; ++k) top4_insert(pv[k], pi[k], tv, ti);
            float pe[4], sum = 0.f;
#pragma unroll
            for (int k = 0; k < 4; ++k) { pe[k] = __expf(tv[k] - tv[0]); sum += pe[k]; }
            const float rs = 1.0f / sum;
            const bool own = kh == 0; int mycnt = 0;
            for (int e = 0; e < NE; ++e) { const bool sel = own && (ti[0] == e || ti[1] == e || ti[2] == e || ti[3] == e); const int c = __builtin_popcountll(__ballot(sel)); if (lane == e) mycnt = c; }
            int basev = 0;
            { LAS int* agc = (LAS int*)(F.lds + 17920); LAS int* agb = agc + 128; volatile LAS int* agf = (volatile LAS int*)(agc + 256);
                const int s_ = F.wave, tag = (tile - T) / (F.G * 4) + 1;
                if (lane < NE) agc[s_ * 32 + lane] = mycnt;
                LDS_WAIT(); if (lane == 0) agf[s_] = tag;
                if (s_ == 0) {
                    for (int sp = 0; sp < (1 << 20) && (agf[1] != tag || agf[2] != tag || agf[3] != tag); ++sp) __builtin_amdgcn_s_sleep(1);
                    int c0 = 0, c1 = 0, c2 = 0, c3 = 0; if (lane < NE) { c0 = agc[lane]; c1 = agc[32 + lane]; c2 = agc[64 + lane]; c3 = agc[96 + lane]; }
                    const int tot = c0 + c1 + c2 + c3; int bs_ = 0; if (lane < NE && tot > 0) bs_ = atomicAdd(&cl[lane], tot);
                    if (lane < NE) { agb[lane] = bs_; agb[32 + lane] = bs_ + c0; agb[64 + lane] = bs_ + c0 + c1; agb[96 + lane] = bs_ + c0 + c1 + c2; }
                    LDS_WAIT(); if (lane == 0) agf[4] = tag; }
                for (int sp = 0; sp < (1 << 20) && agf[4] != tag; ++sp) __builtin_amdgcn_s_sleep(1);
                if (lane < NE) basev = agb[s_ * 32 + lane]; }
            const unsigned long long ltmask = (1ull << lane) - 1ull;
            for (int e = 0; e < NE; ++e) { const bool sel = own && (ti[0] == e || ti[1] == e || ti[2] == e || ti[3] == e); const unsigned long long m = __ballot(sel); const int base = __builtin_amdgcn_readlane(basev, e);
                if (sel) { const int k = ti[0] == e ? 0 : ti[1] == e ? 1 : ti[2] == e ? 2 : 3; const float p = (k == 0 ? pe[0] : k == 1 ? pe[1] : k == 2 ? pe[2] : pe[3]) * rs;
                    const int slot = base + __builtin_popcountll(m & ltmask); rowt[e * CAP + slot] = (tok0 + j) * 4 + k; rowp[e * CAP + slot] = p; } }
        }
    }
    if constexpr (MOE1_FP8 == 0) {
    const float* g = args.in[5] + L * DM;
    u32x2 vn[4];
#pragma unroll
    for (int j = 0; j < 4; ++j) vn[j] = ((const u32x2*)(xs + (size_t)gw * DM))[lane + 64 * j];
    for (int row = gw; row < NTOK; row += NGW) {
        const int b = row / SEQ; f32x4 v[4];
#pragma unroll
        for (int j = 0; j < 4; ++j) v[j] = (f32x4){bf2f(vn[j].x & 0xffffu), bf2f(vn[j].x >> 16), bf2f(vn[j].y & 0xffffu), bf2f(vn[j].y >> 16)};
        if (row + NGW < NTOK) {
#pragma unroll
            for (int j = 0; j < 4; ++j) vn[j] = ((const u32x2*)(xs + (size_t)(row + NGW) * DM))[lane + 64 * j]; }
        if constexpr (MOE1_FP8 != 0) {
            float ss = 0.f;
#pragma unroll
            for (int j = 0; j < 4; ++j) ss += v[j].x * v[j].x + v[j].y * v[j].y + v[j].z * v[j].z + v[j].w * v[j].w;
            const float rstd = rsqrtf(wave_sum(ss) * (1.0f / DM) + EPS);
#pragma unroll
            for (int j = 0; j < 4; ++j) { const int c4 = lane + 64 * j; const f32x4 gg = ((const f32x4*)g)[c4], sh = ((const f32x4*)(ml + 3072 + (size_t)b * 6144))[c4], sc = ((const f32x4*)(ml + 4096 + (size_t)b * 6144))[c4];
                const f32x4 h = (v[j] * rstd * gg * (sc + 1.0f) + sh) * F8_SH; ((unsigned*)((unsigned char*)HA + (size_t)row * DM))[c4] = pk4_fp8(h.x, h.y, h.z, h.w); }
        } else {
            ModP p{g, ml + 3072, ml + 4096, HA + (size_t)row * DM};
            norm_mod_regs<1>(v, b, lane, p, 6144, p, 6144);
        }
    }
    }
}
template <int L> __device__ __forceinline__ const LAS int* moe_table(const Frame& F0, const Args& args) {
    const Frame F = phase_frame(F0);
    LAS int* tab = (LAS int*)(F.lds + MISC_OFF + 64);
    const int* cl = (const int*)(args.ws + WS_CTL) + CW_CNT + L * 64;
    __syncthreads();
    if (F.tid < 32) { const int e = F.tid; const int cn = cl[e]; const int tl = (cn + 255) >> 8; int incl = tl;
#pragma unroll
        for (int o = 1; o < 32; o <<= 1) { const int t = __shfl_up(incl, o, 32); if (e >= o) incl += t; }
        tab[e] = incl - tl; tab[33 + e] = cn; if (e == 31) tab[32] = incl; }
    __syncthreads();
    return tab;
}
template <int L> __device__ __forceinline__ void ph_moe1(const Frame& F, const Args& args) {
    unsigned char* ws = args.ws;
    ProbMoe1 P; P.S.tab = moe_table<L>(F, args); P.S.NN = 8; P.S.G = F.G; P.S.c = F.vcu;
    P.H = (const char*)(ws + WS_HA); P.W1 = (const char*)(ws + WS_W1); P.rowt = (const int*)(ws + WS_ROWT); P.bg = args.in[23] + (size_t)L * NE * DM; P.bu = args.in[25] + (size_t)L * NE * DM; P.Abuf = (unsigned char*)(ws + WS_A);
    pg8::gemm_phase<ProbMoe1, true>(F.lds, P, F.wave);
}
template <int L> __device__ __forceinline__ void ph_moe2(const Frame& F, const Args& args) {
    unsigned char* ws = args.ws;
    ProbMoe2 P; P.S.tab = moe_table<L>(F, args); P.S.NN = 4; P.S.G = F.G; P.S.c = F.vcu;
    P.Abuf = (const char*)(ws + WS_A); P.W2 = (const char*)(ws + WS_W2); P.rowt = (const int*)(ws + WS_ROWT); P.rowp = (const float*)(ws + WS_ROWP); P.bd = args.in[27] + (size_t)L * NE * DM; P.Y = (bf16*)(ws + WS_Y); P.trash = (bf16*)(ws + WS_TRASH);
    pg8::gemm_phase<ProbMoe2, true>(F.lds, P, F.wave);
}
template <int L, bool NORM> __device__ __forceinline__ void ph_combine(const Frame& F0, const Args& args) {
    const Frame F = phase_frame(F0);
    unsigned char* ws = args.ws; const float* mod = (const float*)(ws + WS_MOD); const float* ml = mod + (size_t)L * NB * 6144; const float* kvmod = (const float*)(ws + WS_KVMOD);
    const bf16* Y = (const bf16*)(ws + WS_Y); bf16* HA = (bf16*)(ws + WS_HA); bf16* HB = (bf16*)(ws + WS_HB); float* out = args.out; bf16* xs = (bf16*)(ws + WS_XS);
    const int lane = F.lane; const int gw = F.vcu * NWAVES + F.wave, NGW = F.G * NWAVES;
    const int R = NTOK / NGW; int bcur = -1;
    f32x4 gg[4], akv[4], skv[4], aq[4], sq[4];
    int yn[4][4]; u32x2 xn[4];
#define CMB_LOAD(row_) do { _Pragma("unroll") for (int j_ = 0; j_ < 4; ++j_) { const int c4_ = lane + 64 * j_; \
        _Pragma("unroll") for (int k_ = 0; k_ < 4; ++k_) yn[j_][k_] = ((const int*)((const unsigned char*)Y + (size_t)((row_) * 4 + k_) * DM))[c4_]; \
        xn[j_] = ((const u32x2*)(xs + (size_t)(row_) * DM))[c4_]; } } while (0)
    if (R > 0) CMB_LOAD(gw * R);
    for (int i = 0; i <= R; ++i) {
        const int row = i < R ? gw * R + i : NGW * R + gw; if (i == R && row >= NTOK) break;
        const int b = row / SEQ;
        if (i == R) CMB_LOAD(row);
        int yc[4][4]; u32x2 xc[4];
#pragma unroll
        for (int j = 0; j < 4; ++j) { xc[j] = xn[j];
#pragma unroll
            for (int k = 0; k < 4; ++k) yc[j][k] = yn[j][k]; }
        if (i + 1 < R) CMB_LOAD(row + 1);
        if (b != bcur) { bcur = b;
#pragma unroll
            for (int j = 0; j < 4; ++j) { const int c4 = lane + 64 * j; gg[j] = ((const f32x4*)(ml + 5120 + (size_t)b * 6144))[c4] * (Y_FP8 ? 1.0f / F8_SY : 1.0f);
                if (NORM) { const float* m1 = mod + (size_t)NB * 6144;
                    akv[j] = ((const f32x4*)args.in[14])[c4] * (((const f32x4*)(kvmod + 1024 + (size_t)b * 2048))[c4] + 1.0f); skv[j] = ((const f32x4*)(kvmod + (size_t)b * 2048))[c4];
                    aq[j] = ((const f32x4*)(args.in[4] + DM))[c4] * (((const f32x4*)(m1 + 1024 + (size_t)b * 6144))[c4] + 1.0f); sq[j] = ((const f32x4*)(m1 + (size_t)b * 6144))[c4]; } } }
        f32x4 v[4];
#pragma unroll
        for (int j = 0; j < 4; ++j) { const int c4 = lane + 64 * j; f32x4 s = (f32x4){0.f, 0.f, 0.f, 0.f};
#pragma unroll
            for (int k = 0; k < 4; ++k) {
                if constexpr (Y_FP8 != 0) { const int w = yc[j][k]; const f32x2 lo = __builtin_amdgcn_cvt_pk_f32_fp8(w, false), hi = __builtin_amdgcn_cvt_pk_f32_fp8(w, true); s.x += lo.x; s.y += lo.y; s.z += hi.x; s.w += hi.y; }
                else { const u32x2 w = ((const u32x2*)(Y + (size_t)(row * 4 + k) * DM))[c4]; s.x += bf2f(w.x & 0xffffu); s.y += bf2f(w.x >> 16); s.z += bf2f(w.y & 0xffffu); s.w += bf2f(w.y >> 16); } }
            u32x2* xp = (u32x2*)(xs + (size_t)row * DM) + c4; const u32x2 xw = xc[j];
            v[j] = (f32x4){bf2f(xw.x & 0xffffu), bf2f(xw.x >> 16), bf2f(xw.y & 0xffffu), bf2f(xw.y >> 16)} + gg[j] * s;
            if (NORM) { u32x2 o; o.x = cvt_pk_bf16(v[j].x, v[j].y); o.y = cvt_pk_bf16(v[j].z, v[j].w); *xp = o; }
            else ((f32x4*)(out + (size_t)row * DM))[c4] = v[j]; }
        if (NORM) { float ss = 0.f;
#pragma unroll
            for (int j = 0; j < 4; ++j) ss += v[j].x * v[j].x + v[j].y * v[j].y + v[j].z * v[j].z + v[j].w * v[j].w;
            const float rstd = rsqrtf(wave_sum(ss) * (1.0f / DM) + EPS);
#pragma unroll
            for (int j = 0; j < 4; ++j) { const int c4 = lane + 64 * j; const f32x4 xh = v[j] * rstd; const f32x4 hk = xh * akv[j] + skv[j], hq = xh * aq[j] + sq[j];
                u32x2 wk; wk.x = pk2(hk.x, hk.y); wk.y = pk2(hk.z, hk.w); ((u32x2*)(HA + (size_t)row * DM))[c4] = wk;
                u32x2 wq; wq.x = pk2(hq.x, hq.y); wq.y = pk2(hq.z, hq.w); ((u32x2*)(HB + (size_t)row * DM))[c4] = wq; } }
    }
#undef CMB_LOAD
}

__global__ void __launch_bounds__(NTHREADS, 2) mega(Args args) {
    extern __shared__ __attribute__((aligned(16))) unsigned char lds_raw[];
    Frame FK; Frame& F = FK; F.lds = (LAS unsigned char*)lds_raw; F.wave = __builtin_amdgcn_readfirstlane((int)threadIdx.x >> 6); F.tid = my_tid(F.wave); F.lane = F.tid & 63;
    F.G = gridDim.x; { const int bx = blockIdx.x; F.vcu = (F.G % 8 == 0) ? (bx % 8) * (F.G / 8) + bx / 8 : bx; }
    volatile LAS unsigned* MISC = (volatile LAS unsigned*)(F.lds + MISC_OFF);
    unsigned char* ws = args.ws;
    for (int u = F.tid; u < (LDS_BYTES - MISC_OFF) / 4; u += NTHREADS) MISC[u] = 0u;
    __syncthreads();
    XcdBarrier bar = xcd_barrier_post((unsigned*)(ws + WS_CTL) + CW_BAR, MISC + 8, my_tid(F.wave) == 0);
    const int lo = args.ph_lo, hi = args.ph_hi;
#define IN(k) (lo <= (k) && (k) < hi)
#define SEAM(k) do { if (IN(k) && IN((k) + 1)) xcd_barrier(bar, my_tid(FK.wave) == 0); } while (0)

    if (CK(0) && IN(0)) DUP(0) {
        __syncthreads();
        const Frame F = phase_frame(FK);
        const int gw = F.vcu * NWAVES + F.wave, NGW = F.G * NWAVES;
        float* mod = (float*)(ws + WS_MOD); float* kvmod = (float*)(ws + WS_KVMOD);
        LAS float* cact = (LAS float*)F.lds;
        for (int i = F.tid; i < NB * DM; i += NTHREADS) { const float v = args.in[1][i]; cact[i] = v / (1.0f + __expf(-v)); }
        __syncthreads();
        for (int r = NGW - 1 - gw; r < 896; r += NGW) {
            const int j = r * 16 + (F.lane & 15), kq = F.lane >> 4; const float* W; int ld, col; float bias; float* o; int ostride;
            if (j < 2 * 6144) { const int l = j / 6144; col = j % 6144; W = args.in[2] + (size_t)l * DM * 6144; ld = 6144; bias = args.in[3][l * 6144 + col]; o = mod + (size_t)l * NB * 6144 + col; ostride = 6144; }
            else { col = j - 2 * 6144; W = args.in[12]; ld = 2048; bias = args.in[13][col]; o = kvmod + col; ostride = 2048; }
            float a8[NB];
#pragma unroll
            for (int b = 0; b < NB; ++b) a8[b] = 0.f;
#pragma unroll 16
            for (int k = kq * 256; k < kq * 256 + 256; ++k) { const float w = W[(size_t)k * ld + col];
#pragma unroll
                for (int b = 0; b < NB; ++b) a8[b] += cact[b * DM + k] * w; }
#pragma unroll
            for (int b = 0; b < NB; ++b) { a8[b] += __shfl_xor(a8[b], 16); a8[b] += __shfl_xor(a8[b], 32); }
            if (kq == 0) {
#pragma unroll
                for (int b = 0; b < NB; ++b) o[(size_t)b * ostride] = a8[b] + bias; }
        }
        for (int i = gw * 64 + F.lane; i < NB * NH * 16 * HD / 4; i += NGW * 64) ((f32x4*)(ws + WS_KMEAN))[i] = (f32x4){0.f, 0.f, 0.f, 0.f};
        LAS float* scr = (LAS float*)(F.lds + 32768 + F.wave * 8448);
        constexpr int I_IN = 16 * 192, I_OUT = 48 * 32, I_KV = 16 * 64, I_Q = 16 * 32, I_O = 16 * 32;
        constexpr int NIT = I_IN + I_OUT + I_KV + I_Q + I_O;
        auto decode = [&](int it) -> CvtItem { int r = it;
            if (r < I_IN) return cvt_plain(args.in[6], DM, 6144, ws + WS_WIN, r, SGU1_FP8 != 0); r -= I_IN;
            if (r < I_OUT) return cvt_plain(args.in[11], DS, DM, ws + WS_WOUT, r, false); r -= I_OUT;
            if (r < I_KV) return cvt_plain(args.in[15], DM, 2048, ws + WS_WKV, r, false); r -= I_KV;
            if (r < I_Q) return cvt_plain(args.in[17], DM, DM, ws + WS_WQ, r, false); r -= I_Q;
            return cvt_plain(args.in[19], DM, DM, ws + WS_WO, r, false); };
        if (gw < NIT) { CvtItem cur = decode(gw); f32x4 va[8], vb[8]; cvt_load(cur, va, F.lane);
            for (int it = gw; it < NIT; it += 2 * NGW) {
                const bool h1 = it + NGW < NIT; CvtItem n1 = cur; if (h1) { n1 = decode(it + NGW); cvt_load(n1, vb, F.lane); }
                cvt_store(cur, va, scr, F.lane);
                if (!h1) break;
                const bool h2 = it + 2 * NGW < NIT; if (h2) { cur = decode(it + 2 * NGW); cvt_load(cur, va, F.lane); }
                cvt_store(n1, vb, scr, F.lane);
                if (!h2) break; } }
    }
    SEAM(0);
    if (CK(1) && IN(1)) DUP(1) {
        const Frame F = phase_frame(FK);
        const int gw = F.vcu * NWAVES + F.wave, NGW = F.G * NWAVES; const float* mod = (const float*)(ws + WS_MOD); bf16* HA = (bf16*)(ws + WS_HA); const float* x = args.in[0];
        for (int it = gw; it < 2 * NB * NE; it += NGW) {
            const int e = it & 31, b = (it >> 5) & 7, l = it >> 8; const float* m_ = mod + (size_t)(l * NB + b) * 6144; const float* w = args.in[20] + (size_t)l * DM * NE; const float* g2 = args.in[5] + l * DM;
            u32x4* wt3 = (u32x4*)(ws + WS_RW3) + (size_t)(l * NB + b) * (2 * 32 * 3 * 64); float c = 0.f;
#pragma unroll
            for (int i2 = 0; i2 < 2; ++i2) { const int ch = F.lane + 64 * i2, k0 = 8 * ch;
                float wv[8];
#pragma unroll
                for (int p = 0; p < 8; ++p) wv[p] = w[(k0 + p) * NE + e];
                const f32x4 ga = *(const f32x4*)(g2 + k0), gb = *(const f32x4*)(g2 + k0 + 4), sa = *(const f32x4*)(m_ + 4096 + k0), sb = *(const f32x4*)(m_ + 4096 + k0 + 4), ha = *(const f32x4*)(m_ + 3072 + k0), hb = *(const f32x4*)(m_ + 3072 + k0 + 4);
                unsigned hi[8], mi[8], lo[8];
#pragma unroll
                for (int p = 0; p < 8; ++p) { const float gv = p < 4 ? ga[p & 3] : gb[p & 3], sv = p < 4 ? sa[p & 3] : sb[p & 3], hv = p < 4 ? ha[p & 3] : hb[p & 3];
                    const float a_ = gv * (1.0f + sv) * wv[p]; c += hv * wv[p];
                    hi[p] = __builtin_bit_cast(unsigned, a_) & 0xffff0000u; const float r1 = a_ - __builtin_bit_cast(float, hi[p]);
                    mi[p] = __builtin_bit_cast(unsigned, r1) & 0xffff0000u; lo[p] = __builtin_bit_cast(unsigned, r1 - __builtin_bit_cast(float, mi[p])); }
                const int kq_ = i2, s_ = (ch >> 1) & 31, kh_ = ch & 1; u32x4* dst = wt3 + (size_t)((kq_ * 32 + s_) * 3) * 64 + e + 32 * kh_;
                dst[0]   = (u32x4){(hi[0] >> 16) | hi[1], (hi[2] >> 16) | hi[3], (hi[4] >> 16) | hi[5], (hi[6] >> 16) | hi[7]};
                dst[64]  = (u32x4){(mi[0] >> 16) | mi[1], (mi[2] >> 16) | mi[3], (mi[4] >> 16) | mi[5], (mi[6] >> 16) | mi[7]};
                dst[128] = (u32x4){(lo[0] >> 16) | (lo[1] & 0xffff0000u), (lo[2] >> 16) | (lo[3] & 0xffff0000u), (lo[4] >> 16) | (lo[5] & 0xffff0000u), (lo[6] >> 16) | (lo[7] & 0xffff0000u)}; }
            c = wave_sum(c); if (F.lane == 0) ((float*)(ws + WS_RCB))[it] = c + args.in[21][l * NE + e];
        }
        { const int R = NTOK / NGW; int bcur = -1; f32x4 am[4], sm[4], vn[4];
            const int row0 = gw * R;
#pragma unroll
            for (int j = 0; j < 4; ++j) vn[j] = ((const f32x4*)(x + (size_t)(R > 0 ? row0 : gw) * DM))[F.lane + 64 * j];
            for (int i = 0; i <= R; ++i) {
                const int row = i < R ? row0 + i : NGW * R + gw; if (i == R && row >= NTOK) break;
                const int b = row / SEQ; f32x4 v[4];
                if (i == R && R > 0) {
#pragma unroll
                    for (int j = 0; j < 4; ++j) vn[j] = ((const f32x4*)(x + (size_t)row * DM))[F.lane + 64 * j]; }
#pragma unroll
                for (int j = 0; j < 4; ++j) v[j] = vn[j];
                if (i + 1 < R) {
#pragma unroll
                    for (int j = 0; j < 4; ++j) vn[j] = ((const f32x4*)(x + (size_t)(row + 1) * DM))[F.lane + 64 * j]; }
                if (b != bcur) { bcur = b;
#pragma unroll
                    for (int j = 0; j < 4; ++j) { const int c4 = F.lane + 64 * j; am[j] = ((const f32x4*)args.in[4])[c4] * (((const f32x4*)(mod + 1024 + (size_t)b * 6144))[c4] + 1.0f); sm[j] = ((const f32x4*)(mod + (size_t)b * 6144))[c4]; } }
                float ss = 0.f;
#pragma unroll
                for (int j = 0; j < 4; ++j) ss += v[j].x * v[j].x + v[j].y * v[j].y + v[j].z * v[j].z + v[j].w * v[j].w;
                const float rstd = rsqrtf(wave_sum(ss) * (1.0f / DM) + EPS);
#pragma unroll
                for (int j = 0; j < 4; ++j) { const int c4 = F.lane + 64 * j; const f32x4 h = v[j] * rstd * am[j] + sm[j];
                    if constexpr (SGU1_FP8 != 0) { const f32x4 h8 = h * F8_SH; ((unsigned*)((unsigned char*)HA + (size_t)row * DM))[c4] = pk4_fp8(h8.x, h8.y, h8.z, h8.w); }
                    else { u32x2 w; w.x = pk2(h.x, h.y); w.y = pk2(h.z, h.w); ((u32x2*)(HA + (size_t)row * DM))[c4] = w; } } } }
    }
    SEAM(1);
    if (CK(2) && IN(2)) {
        ProbSguIn P; P.A = (const char*)(ws + WS_HA); P.Bt = (const char*)(ws + WS_WIN); P.S.init(NTOK, 6144, F.G, (int)blockIdx.x); P.bias = args.in[7]; P.U = (bf16*)(ws + WS_U); P.V = (bf16*)(ws + WS_V); P.vpart = (float*)(ws + WS_VPART);
        P.side.wg = args.in[22]; P.side.wu = args.in[24]; P.side.wd = args.in[26]; P.side.W1 = ws + WS_W1; P.side.W2 = ws + WS_W2; P.side.trash = ws + WS_TRASH; P.side.c = F.vcu; P.side.G = F.G;
        if constexpr (ProbSguIn::SIDE) { DUP(2) pg8::gemm_phase<ProbSguIn, true>(F.lds, P, F.wave); }
        else { DUP(2) { const int kc = F.vcu % 12;
            P.S.i0 = 0; P.S.i1 = kc; pg8::gemm_phase<ProbSguIn, true>(F.lds, P, F.wave);
            __syncthreads(); cvt_moe_share(FK, args, 0); __syncthreads();
            P.S.i0 = kc; P.S.i1 = 1 << 30; pg8::gemm_phase<ProbSguIn, true>(F.lds, P, F.wave); } }
    }
    SEAM(2);
    if (CK(3) && IN(3)) {
        const Frame F = phase_frame(FK);
        constexpr int VS = 800, AS = 272, OFF_A = 128 * VS, OFF_RS = OFF_A + 128 * AS, OFF_VG = OFF_RS + 512;
        bf16* U = (bf16*)(ws + WS_U); const bf16* V = (const bf16*)(ws + WS_V); const float* vpart = (const float*)(ws + WS_VPART);
        const float* w_s = args.in[9]; const float* b_s = args.in[10]; const float* v_g = args.in[8];
        LAS unsigned char* Vs = F.lds; LAS unsigned char* As = F.lds + OFF_A; LAS float* rs = (LAS float*)(F.lds + OFF_RS);
        const int lane = F.lane, w = F.wave, gq = lane >> 4, li = lane & 15;
        for (int chunk = F.vcu; chunk < NTOK / 128; chunk += F.G) {
            const int tok0 = chunk * 128;
            __syncthreads();
            if (F.tid < 128) { const float* pp = vpart + (size_t)(tok0 + F.tid) * 48; float ss = 0.f;
#pragma unroll
                for (int q = 0; q < 12; ++q) { const f32x4 a = ((const f32x4*)pp)[q]; ss += (a.x + a.y) + (a.z + a.w); }
                rs[F.tid] = rsqrtf(ss * (1.0f / DS) + EPS); }
            u32x4 vreg[12], ureg[12];
            const unsigned goff = (unsigned)((F.tid >> 4) * DS + (F.tid & 15) * 8) * 2u, loff = (unsigned)((F.tid >> 4) * VS + (F.tid & 15) * 16);
            const char* Vc = (const char*)(V + (size_t)tok0 * DS); char* Uc = (char*)(U + (size_t)tok0 * DS);
#define MIX_G(rb, cb) ((size_t)(rb) * 32 * DS * 2 + (cb) * 256)
#define MIX_L(rb, cb) ((rb) * 32 * VS + (cb) * 256)
#pragma unroll
            for (int i = 0; i < 12; ++i) vreg[i] = *(const u32x4*)(Vc + MIX_G(i / 3, i % 3) + goff);
#pragma unroll 1
            for (int g = 0; g < 8; ++g) {
                const int ch0 = g * 384;
                __syncthreads();
                int tq_ = F.tid; asm volatile("" : "+v"(tq_));
#pragma unroll
                for (int i = 0; i < 12; ++i) *(LAS u32x4*)(Vs + MIX_L(i / 3, i % 3) + loff) = vreg[i];
                const float bsv = b_s[g * 128 + ((tq_ >> 6) * 16 + (tq_ & 15))];
                { const int slot = (tq_ & 63) * 2, ks_ = slot >> 5, q4 = (slot >> 3) & 3, j_ = slot & 7, t0 = tq_ >> 6;
                    const int sx = 32 * ks_ + 16 * (q4 >> 1) + 8 * (j_ >> 2) + 4 * (q4 & 1) + (j_ & 3); const float r0 = rs[sx], r1 = rs[sx + 1];
                    const float* wp = w_s + ((size_t)g * 128 + t0) * 128 + sx; LAS unsigned char* ap = As + t0 * AS + slot * 2;
                    const f32x4 vgl = ((const f32x4*)(v_g + ch0))[tq_ < 96 ? tq_ : 0];
                    f32x2 wv[16];
#pragma unroll
                    for (int i = 0; i < 16; ++i) wv[i] = *(const f32x2*)(wp + i * 1024);
                    __builtin_amdgcn_sched_barrier(0);
#pragma unroll
                    for (int i = 0; i < 16; ++i) { const int t = t0 + 8 * i;
                        const float a = (sx <= t) ? wv[i].x * r0 : 0.f, b = (sx + 1 <= t) ? wv[i].y * r1 : 0.f;
                        *(LAS unsigned*)(ap + i * 8 * AS) = pk2(a, b); }
                    if (tq_ < 96) ((LAS f32x4*)(F.lds + OFF_VG))[tq_] = vgl; }
                __builtin_amdgcn_sched_barrier(0);
#pragma unroll
                for (int i = 0; i < 12; ++i) ureg[i] = *(const u32x4*)(Uc + (size_t)ch0 * 2 + MIX_G(i / 3, i % 3) + goff);
                if (g < 7) {
#pragma unroll
                    for (int i = 0; i < 12; ++i) vreg[i] = *(const u32x4*)(Vc + (size_t)(ch0 + 384) * 2 + MIX_G(i / 3, i % 3) + goff); }
                __syncthreads();
                f32x4 acc[24];
#pragma unroll
                for (int n = 0; n < 24; ++n) acc[n] = (f32x4){0.f, 0.f, 0.f, 0.f};
                const int kmax = w >> 1;
#pragma unroll 1
                for (int ks = 0; ks <= kmax; ++ks) {
                    const bf16x8 af = *(const LAS bf16x8*)(As + (16 * w + li) * AS + (32 * ks + 8 * gq) * 2);
                    const LAS unsigned char* vb = Vs + (32 * ks + 16 * (gq >> 1) + 4 * (gq & 1) + (li >> 2)) * VS + (li & 3) * 8;
#pragma unroll
                    for (int n = 0; n < 24; ++n) {
                        const attn_body::s16x4 lo = attn_body::vtr((attn_body::lds_cptr)(vb + n * 32)), hi = attn_body::vtr((attn_body::lds_cptr)(vb + n * 32 + 8 * VS));
                        const bf16x8 vf = (bf16x8){lo[0], lo[1], lo[2], lo[3], hi[0], hi[1], hi[2], hi[3]};
                        acc[n] = __builtin_amdgcn_mfma_f32_16x16x32_bf16(vf, af, acc[n], 0, 0, 0); if ((n & 3) == 3) __builtin_amdgcn_sched_barrier(0); }
                }
                __syncthreads();
                { const int t = 16 * w + li; const float bs = bsv; LAS const unsigned char* vgb = F.lds + OFF_VG + 16 * ((tq_ >> 4) & 3); asm volatile("" : "+v"(vgb));
#pragma unroll
                    for (int n = 0; n < 24; ++n) { const f32x4 vg = *(const LAS f32x4*)(vgb + n * 64); const f32x4 gt = vg * acc[n] + bs;
                        u32x2 o; o.x = pk2(gt[0], gt[1]); o.y = pk2(gt[2], gt[3]); *(LAS u32x2*)(Vs + t * VS + (16 * n + 4 * gq) * 2) = o; if ((n & 1) == 1) __builtin_amdgcn_sched_barrier(0); } }
                __syncthreads();
#pragma unroll
                for (int i = 0; i < 12; ++i) {
                    const u32x4 gv = *(const LAS u32x4*)(Vs + MIX_L(i / 3, i % 3) + loff); const u32x4 uv = ureg[i]; u32x4 o;
#pragma unroll
                    for (int q = 0; q < 4; ++q) o[q] = pk2(bf2f(uv[q] & 0xffffu) * bf2f(gv[q] & 0xffffu), bf2f(uv[q] >> 16) * bf2f(gv[q] >> 16));
                    *(u32x4*)(Uc + (size_t)ch0 * 2 + MIX_G(i / 3, i % 3) + goff) = o; }
            }
        }
    }
#undef MIX_G
#undef MIX_L
    SEAM(3);
    if (CK(4) && IN(4)) {
        ProbResid<3072, false> P; P.A = (const char*)(ws + WS_U); P.Bt = (const char*)(ws + WS_WOUT); P.S.init(NTOK, DM, F.G, (int)blockIdx.x); P.xin = args.in[0]; P.xout = (bf16*)(ws + WS_XS); P.gate = (const float*)(ws + WS_MOD) + 2048;
        DUP(4) pg8::gemm_phase<ProbResid<3072, false>, true>(F.lds, P, F.wave);
    }
    SEAM(4);
    if (CK(5) && IN(5)) ph_router<0>(F, args);
    SEAM(5);
    if (CK(6) && IN(6)) DUP(6) ph_moe1<0>(F, args);
    SEAM(6);
    if (CK(7) && IN(7)) DUP(7) ph_moe2<0>(F, args);
    SEAM(7);
    if (CK(8) && IN(8)) {
        ph_combine<0, true>(FK, args);
    }
    SEAM(8);
    if (CK(9) && IN(9)) {
        ProbHead P; P.A = (const char*)(ws + WS_HA); P.Bt = (const char*)(ws + WS_WKV); P.A2 = (const char*)(ws + WS_HB); P.Bt2 = (const char*)(ws + WS_WQ); P.S.init(NTOK, 3072, F.G, (int)blockIdx.x);
        P.kg = args.in[16]; P.qg = args.in[18]; P.Kb = (bf16*)(ws + WS_K); P.Vb = (bf16*)(ws + WS_VV); P.Qb = (bf16*)(ws + WS_Q); P.kmean = (float*)(ws + WS_KMEAN);
        DUP(9) pg8::gemm_phase<ProbHead, true>(F.lds, P, F.wave);
    }
    SEAM(9);
    if (CK(10) && IN(10)) {
        const attn_body::AttnTensors AT{(const attn_body::bf16*)(ws + WS_Q), (const attn_body::bf16*)(ws + WS_K), (const attn_body::bf16*)(ws + WS_VV), (attn_body::bf16*)(ws + WS_O)};
        const attn_body::StaticOrder S((int)F.G, (int)blockIdx.x);
        DUP(10) { attn_body::AttnUnit u, un; const int kc = F.vcu & 7;
            const float* KM = (const float*)(ws + WS_KMEAN); attn_body::bf16x8 qr[4]; attn_body::f32x2_t kmv;
            if (S.next(0, u)) { if (kc != 0) attn_body::attn_preload(u.bh / attn_body::NHEAD, u.bh % attn_body::NHEAD, u.qb, AT.Q, KM + (size_t)u.bh * 16 * 64, qr, kmv, F.wave);
                for (int i = 0;; ++i) {
                    if (i == kc) { __syncthreads(); cvt_moe_share(FK, args, 1); __syncthreads();
                        attn_body::attn_preload(u.bh / attn_body::NHEAD, u.bh % attn_body::NHEAD, u.qb, AT.Q, KM + (size_t)u.bh * 16 * 64, qr, kmv, F.wave); }
                    const bool hn = S.next(i + 1, un); if (!hn) un = u;
                    attn_body::attn_unit(u.bh / attn_body::NHEAD, u.bh % attn_body::NHEAD, u.qb, AT.Q, AT.K, AT.V, AT.O, (char*)lds_raw, F.wave, qr, kmv, un.bh / attn_body::NHEAD, un.bh % attn_body::NHEAD, un.qb, KM + (size_t)un.bh * 16 * 64);
                    if (!hn) break; u = un; } } }
    }
    SEAM(10);
    if (CK(11) && IN(11)) {
        ProbResid<1024, true> P; P.A = (const char*)(ws + WS_O); P.Bt = (const char*)(ws + WS_WO); P.S.init(NTOK, DM, F.G, (int)blockIdx.x); P.xin = ws + WS_XS; P.xout = (bf16*)(ws + WS_XS); P.gate = (const float*)(ws + WS_MOD) + (size_t)NB * 6144 + 2048;
        pg8::gemm_phase<ProbResid<1024, true>, true>(F.lds, P, F.wave);
    }
    SEAM(11);
    if (CK(5) && IN(12)) ph_router<1>(F, args);
    SEAM(12);
    if (CK(6) && IN(13)) ph_moe1<1>(F, args);
    SEAM(13);
    if (CK(7) && IN(14)) ph_moe2<1>(F, args);
    SEAM(14);
    if (CK(15) && IN(15)) ph_combine<1, false>(F, args);
#undef IN
#undef SEAM
}

extern "C" void kernel_launch(void* const* d_in, const int* in_sizes, int n_in, void* d_out, int out_size, void* d_ws, size_t ws_size, hipStream_t stream) {
    static int grid = 0;
    if (grid == 0) {
        if (n_in != 28 || ws_size < WS_END || out_size != NTOK * DM) { fprintf(stderr, "kernel_launch: unexpected sizes n_in=%d ws=%zu out=%d\n", n_in, ws_size, out_size); grid = -1; return; }
        int dev = 0, cus = 0, per_cu = 0;
        if (hipGetDevice(&dev) != hipSuccess || hipDeviceGetAttribute(&cus, hipDeviceAttributeMultiprocessorCount, dev) != hipSuccess) { grid = -1; return; }
        if (hipFuncSetAttribute((const void*)mega, hipFuncAttributeMaxDynamicSharedMemorySize, LDS_BYTES) != hipSuccess) { fprintf(stderr, "kernel_launch: hipFuncSetAttribute failed\n"); grid = -1; return; }
        if (hipOccupancyMaxActiveBlocksPerMultiprocessor(&per_cu, (const void*)mega, NTHREADS, LDS_BYTES) != hipSuccess || per_cu < 1) { fprintf(stderr, "kernel_launch: occupancy query says %d\n", per_cu); }
        (void)hipGetLastError();
        grid = cus;
    }
    if (grid < 0) return;
    (void)hipMemsetAsync((char*)d_ws + WS_CTL, 0, CTL_ZERO_BYTES, stream);
    Args a{};
    for (int i = 0; i < 28; ++i) a.in[i] = (const float*)d_in[i];
    a.out = (float*)d_out; a.ws = (unsigned char*)d_ws; a.ph_lo = 0; a.ph_hi = 16;
    hipLaunchKernelGGL(mega, dim3(grid), dim3(NTHREADS), LDS_BYTES, stream, a);
}
```
